# Optimizing an MI355X kernel written in HIP

```python
import jax, jax.numpy as jnp
from jax import lax
import numpy as np

D_MODEL = 1024
BATCH = 2
SEQ = 8192
DEPTH = 1

GRID_W = 64
CTX_LEN = 256
CONV_W = 1024
CONV_K = 3
N_HEADS = 16
HEAD_DIM = 64
ATTN_W = N_HEADS * HEAD_DIM
WIN_ROWS_MAX = 8
WIN_COLS = 16
ROPE_BASE = 10000.0
EPS = 1e-6
N_BRANCH = 2
IN_SIZES = [CONV_W] * 4 + [ATTN_W] * 4 + [D_MODEL] * N_BRANCH
IN_COLS = sum(IN_SIZES)
K_OFF = 4 * CONV_W + ATTN_W
V_END = 4 * CONV_W + 3 * ATTN_W

kernel_name = "hybrid_gated_conv_neighbourhood_attn_block"


def _rmsnorm(u, g):
    u32 = u.astype(jnp.float32)
    return (u32 * lax.rsqrt(jnp.mean(u32 * u32, axis=-1, keepdims=True) + EPS)).astype(u.dtype) * g


def _modulation(cond, w_mod, b_mod):
    m = jax.nn.silu(cond) @ w_mod + b_mod
    return jnp.split(m, 3, axis=-1)


def _split_in(p):
    idx = np.cumsum(IN_SIZES)[:-1].tolist()
    return jnp.split(p, idx, axis=-1)


def _dwconv3(u, w, b):
    L = u.shape[1]
    up = jnp.pad(u, ((0, 0), (1, 1), (0, 0)))
    return up[:, :L] * w[0] + up[:, 1:L + 1] * w[1] + up[:, 2:] * w[2] + b


def _rope_2d_tables(L, dtype):
    t = jnp.arange(L, dtype=jnp.int32)
    row = (t // GRID_W).astype(jnp.float32)
    col = (t % GRID_W).astype(jnp.float32)
    half = HEAD_DIM // 2
    inv = ROPE_BASE ** (-jnp.arange(0, half, 2, dtype=jnp.float32) / half)
    ang_r = row[:, None] * inv
    ang_c = col[:, None] * inv
    ang = jnp.concatenate([ang_r, ang_r, ang_c, ang_c], axis=-1)
    return jnp.cos(ang).astype(dtype), jnp.sin(ang).astype(dtype)


def _rot_half_axial(u):
    u1, u2, u3, u4 = jnp.split(u, 4, axis=-1)
    return jnp.concatenate([-u2, u1, -u4, u3], axis=-1)


def _apply_rope(u, cos, sin):
    return u * cos[None, :, None, :] + _rot_half_axial(u) * sin[None, :, None, :]


def _heads(u):
    return u.reshape(u.shape[0], u.shape[1], N_HEADS, HEAD_DIM)


def _neighbourhood_attention(q, k, v, k_ctx, v_ctx, rpb):
    bsz, L, H, Dh = q.shape
    rows = L // GRID_W
    wr = min(WIN_ROWS_MAX, rows)
    n_nb = wr * WIN_COLS
    scale = HEAD_DIM ** -0.5
    qg = q.reshape(bsz, rows, GRID_W, H, Dh)
    kg = k.reshape(bsz, rows, GRID_W, H, Dh)
    vg = v.reshape(bsz, rows, GRID_W, H, Dh)
    col = jnp.arange(GRID_W, dtype=jnp.int32)
    col_start = jnp.clip(col - WIN_COLS // 2, 0, GRID_W - WIN_COLS)
    col_idx = col_start[:, None] + jnp.arange(WIN_COLS, dtype=jnp.int32)
    dc_idx = col_idx - col[:, None] + (WIN_COLS - 1)

    def row_block(r):
        rs = jnp.clip(r - wr // 2, 0, rows - wr)
        q_r = lax.dynamic_index_in_dim(qg, r, axis=1, keepdims=False)
        k_slab = lax.dynamic_slice_in_dim(kg, rs, wr, axis=1)
        v_slab = lax.dynamic_slice_in_dim(vg, rs, wr, axis=1)
        k_win = k_slab[:, :, col_idx]
        v_win = v_slab[:, :, col_idx]
        dr_idx = rs + jnp.arange(wr, dtype=jnp.int32) - r + (WIN_ROWS_MAX - 1)
        bias = rpb[:, dr_idx[None, :, None], dc_idx[:, None, :]]
        s_nb = (jnp.einsum('bqhd,bpqjhd->bqhpj', q_r, k_win).astype(jnp.float32) * scale
                + jnp.transpose(bias, (1, 0, 2, 3))[None].astype(jnp.float32))
        s_nb = s_nb.reshape(bsz, GRID_W, H, n_nb)
        s_ctx = jnp.einsum('bqhd,bchd->bqhc', q_r, k_ctx).astype(jnp.float32) * scale
        p = jax.nn.softmax(jnp.concatenate([s_nb, s_ctx], axis=-1), axis=-1).astype(v.dtype)
        p_nb = p[..., :n_nb].reshape(bsz, GRID_W, H, wr, WIN_COLS)
        p_ctx = p[..., n_nb:]
        return (jnp.einsum('bqhpj,bpqjhd->bqhd', p_nb, v_win)
                + jnp.einsum('bqhc,bchd->bqhd', p_ctx, v_ctx))

    out = lax.map(row_block, jnp.arange(rows, dtype=jnp.int32))
    return jnp.transpose(out, (1, 0, 2, 3, 4)).reshape(bsz, L, H * Dh)


def _ctx_attention(q, k, v):
    scale = HEAD_DIM ** -0.5
    s = jnp.einsum('bqhd,bkhd->bhqk', q, k).astype(jnp.float32) * scale
    p = jax.nn.softmax(s, axis=-1).astype(v.dtype)
    o = jnp.einsum('bhqk,bkhd->bqhd', p, v)
    return o.reshape(o.shape[0], o.shape[1], ATTN_W)


def _mixer_out(parts, attn_o, conv_w, conv_b, w_out_conv, w_out_attn, w_o):
    b_gate, c_gate, x_in, z_a, _, _, _, z_b, g_a, g_b = parts
    y_a = (jax.nn.silu(z_a) * b_gate * _dwconv3(c_gate * x_in, conv_w, conv_b)) @ w_out_conv
    y_b = (jax.nn.silu(z_b) * attn_o) @ w_out_attn
    merged = jax.nn.sigmoid(g_a) * y_a + jax.nn.sigmoid(g_b) * y_b
    return merged @ w_o


def setup_inputs(seed: int = 0) -> dict:
    key = jax.random.key(seed)
    ks = jax.random.split(key, 16)
    f32 = jnp.float32
    nrm = lambda k, shape, s: jax.random.normal(k, shape, f32) * s
    return {
        "x": nrm(ks[0], (BATCH, SEQ, D_MODEL), 1.0),
        "c": nrm(ks[1], (BATCH, D_MODEL), 1.0),
        "ctx": nrm(ks[2], (BATCH, CTX_LEN, D_MODEL), 1.0),
        "c_ctx": nrm(ks[3], (D_MODEL,), 1.0),
        "w_mod": nrm(ks[4], (DEPTH, D_MODEL, 3 * D_MODEL), D_MODEL ** -0.5),
        "b_mod": nrm(ks[5], (DEPTH, 3 * D_MODEL), 0.02),
        "pre_g": 1.0 + nrm(ks[6], (DEPTH, D_MODEL), 0.05),
        "post_g": 1.0 + nrm(ks[7], (DEPTH, D_MODEL), 0.05),
        "w_in": nrm(ks[8], (DEPTH, D_MODEL, IN_COLS), D_MODEL ** -0.5),
        "conv_w": nrm(ks[9], (DEPTH, CONV_K, CONV_W), CONV_K ** -0.5),
        "conv_b": nrm(ks[10], (DEPTH, CONV_W), 0.02),
        "rpb": nrm(ks[11], (DEPTH, N_HEADS, 2 * WIN_ROWS_MAX - 1, 2 * WIN_COLS - 1), 0.1),
        "w_out_conv": nrm(ks[12], (DEPTH, CONV_W, D_MODEL), CONV_W ** -0.5),
        "w_out_attn": nrm(ks[13], (DEPTH, ATTN_W, D_MODEL), ATTN_W ** -0.5),
        "w_o": nrm(ks[14], (DEPTH, D_MODEL, D_MODEL), D_MODEL ** -0.5),
    }


def reference(x, c, ctx, c_ctx, w_mod, b_mod, pre_g, post_g, w_in, conv_w, conv_b, rpb,
              w_out_conv, w_out_attn, w_o):
    L = x.shape[1]
    cos, sin = _rope_2d_tables(L, x.dtype)
    for i in range(DEPTH):
        last = i == DEPTH - 1
        sh, sc, gt = _modulation(c, w_mod[i], b_mod[i])
        sh_c, sc_c, gt_c = _modulation(c_ctx, w_mod[i], b_mod[i])
        h = _rmsnorm(x, pre_g[i]) * (1.0 + sc[:, None, :]) + sh[:, None, :]
        hc = _rmsnorm(ctx, pre_g[i]) * (1.0 + sc_c) + sh_c
        parts = _split_in(h @ w_in[i])
        q = _apply_rope(_heads(parts[4]), cos, sin)
        k = _apply_rope(_heads(parts[5]), cos, sin)
        v = _heads(parts[6])
        if last:
            kv_c = hc @ w_in[i][:, K_OFF:V_END]
            k_c, v_c = jnp.split(kv_c, 2, axis=-1)
            k_c, v_c = _heads(k_c), _heads(v_c)
        else:
            parts_c = _split_in(hc @ w_in[i])
            k_c, v_c = _heads(parts_c[5]), _heads(parts_c[6])
        attn = _neighbourhood_attention(q, k, v, k_c, v_c, rpb[i])
        y = _mixer_out(parts, attn, conv_w[i], conv_b[i], w_out_conv[i], w_out_attn[i], w_o[i])
        if not last:
            attn_c = _ctx_attention(_heads(parts_c[4]), k_c, v_c)
            y_c = _mixer_out(parts_c, attn_c, conv_w[i], conv_b[i], w_out_conv[i], w_out_attn[i], w_o[i])
            ctx = ctx + gt_c * _rmsnorm(y_c, post_g[i])
        x = x + gt[:, None, :] * _rmsnorm(y, post_g[i])
    return x
```

```cpp
#ifndef PROBE_FLAGS
#define PROBE_FLAGS 0
#endif
#include <hip/hip_runtime.h>
#include <hip/hip_cooperative_groups.h>
#include <cstdio>
#include <cstdint>
namespace cg = cooperative_groups;
#define DI __device__ __forceinline__
typedef float f32x2_t __attribute__((ext_vector_type(2)));
typedef __bf16 bf16x2_t __attribute__((ext_vector_type(2)));
typedef float f32x16 __attribute__((ext_vector_type(16)));
typedef unsigned u32x2 __attribute__((ext_vector_type(2)));
DI unsigned pk2(float lo, float hi) { f32x2_t v = {lo, hi}; bf16x2_t b = __builtin_convertvector(v, bf16x2_t); return __builtin_bit_cast(unsigned, b); }
DI float bflo(unsigned u) { return __uint_as_float(u << 16); }
DI float bfhi(unsigned u) { return __uint_as_float(u & 0xffff0000u); }
DI float fsigm(float z) { return __builtin_amdgcn_rcpf(1.0f + __builtin_amdgcn_exp2f(z * -1.4426950408889634f)); }
DI float fsilu(float z) { return z * fsigm(z); }
namespace pg8 {
#define PG8_LAS __attribute__((address_space(3)))
typedef unsigned short bf16_t;
typedef short bf16x8 __attribute__((ext_vector_type(8)));
typedef float f32x4 __attribute__((ext_vector_type(4)));
typedef unsigned u32x4 __attribute__((ext_vector_type(4)));
constexpr int BM = 256, BK = 64, HALF = 128, HTB = HALF * BK * 2  , STAGE_BYTES = 8 * HTB, NXCD = 8, WGM = 8;

__host__ __device__ __forceinline__ int lds_byte(int r, int c) { const int st = (r >> 4) * 2 + (c >> 5), rr = r & 15, cc = c & 31, ob = rr * 64 + cc * 2; return st * 1024 + (ob ^ (((ob >> 9) & 1) << 5)); }
__host__ __device__ __forceinline__ void stage_rc(int b, int& R, int& C) { const int st = b / 1024, sb = b % 1024, swz = sb ^ (((sb >> 9) & 1) << 5); R = (st >> 1) * 16 + swz / 64; C = (st & 1) * 32 + (swz % 64) / 2; }
__host__ __device__ __forceinline__ int perm32(int rho) { const int n = rho >> 4, i = rho & 15; return 8 * (i >> 2) + 4 * n + (i & 3); }

struct Unit { int pm, pn; };
struct Gemm { const bf16_t* A; const bf16_t* Bt; int M, N, K; };

struct StaticOrder {
    int nM, nN, nwg, G, c;
    __host__ __device__ void init(int M, int N, int G_, int c_) { nM = M / BM; nN = N / BM; nwg = nM * nN; G = G_; c = c_; }
    __host__ __device__ bool next(int i, Unit& u) const {
        const long L = (long)i * G + c; if (L >= nwg) return false;
        int wgid = (int)L; { const int q = nwg / NXCD, r = nwg % NXCD, xcd = wgid % NXCD, off = wgid / NXCD; wgid = (xcd < r ? xcd * (q + 1) : r * (q + 1) + (xcd - r) * q) + off; }
        const int nig = WGM * nN, gid = wgid / nig, fm = gid * WGM, gsz = (nM - fm) < WGM ? (nM - fm) : WGM;
        u.pm = fm + ((wgid % nig) % gsz); u.pn = (wgid % nig) / gsz; return true;
    }
    __device__ __forceinline__ void a_ready(const Unit&) const {}
    __device__ __forceinline__ void done(const Unit&) const {}
};

template <class Epi, class Sched, bool ALIGN_EPI = false, bool SP2 = false, bool SWAP = false, bool HOOK = false, bool PERMA = false  >
__device__ __forceinline__ void gemm_phase(PG8_LAS unsigned char* lds, const Gemm g, const Sched& S, const Epi& E) {
    int tid_ = threadIdx.x; asm volatile("" : "+v"(tid_));
    const int tid = tid_, wid = __builtin_amdgcn_readfirstlane(tid >> 6), lane = tid & 63, wr = wid >> 2, wc = wid & 3, fr = lane & 15, fq = lane >> 4;
    const int K = g.K, nt = K / BK;
    unsigned voffA[2], voffB[2];
#pragma unroll
    for (int i = 0; i < 2; ++i) { int R, C; stage_rc(tid * 16 + i * 8192, R, C); const int Rb = R; const int Ra = PERMA ? ((R & ~31) + perm32(R & 31)) : R;
        voffA[i] = (unsigned)(Ra * K + C) * 2u; voffB[i] = (unsigned)(Rb * K + C) * 2u; }
    const size_t kstep = (size_t)(BK * 2);
    const size_t hstep = (size_t)HALF * K * 2;
    const size_t tstep = 2 * hstep;
    const unsigned ldsw = (unsigned)wid * 1024u;
    const int aoff = lds_byte(wr * 64 + fr, fq * 8), boff = lds_byte(wc * 32 + fr, fq * 8);
#define PG8_SA(b, h) (((b) * 2 + (h)) * HTB)
#define PG8_SB(b, h) ((4 + (b) * 2 + (h)) * HTB)
#define PG8_STAGE(bufoff, gbase, voff) do { _Pragma("unroll") for (int _i = 0; _i < 2; ++_i) \
        __builtin_amdgcn_global_load_lds((const unsigned*)((const char*)(gbase) + (voff)[_i]), (PG8_LAS unsigned*)(lds + (bufoff) + ldsw + _i * 8192), 16, 0, 0); } while (0)
#define PG8_LDA(dst, b, h) do { _Pragma("unroll") for (int m = 0; m < 4; ++m) _Pragma("unroll") for (int k = 0; k < 2; ++k) dst[m][k] = *(const PG8_LAS bf16x8*)(lds + PG8_SA(b, h) + aoff + m * 2048 + k * 1024); } while (0)
#define PG8_LDB(dst, b, h) do { _Pragma("unroll") for (int n = 0; n < 2; ++n) _Pragma("unroll") for (int k = 0; k < 2; ++k) dst[n][k] = *(const PG8_LAS bf16x8*)(lds + PG8_SB(b, h) + boff + n * 2048 + k * 1024); } while (0)
#define PG8_MMA(ai, bj, At, Bt) do { __builtin_amdgcn_s_setprio(1); _Pragma("unroll") for (int m = 0; m < 4; ++m) _Pragma("unroll") for (int n = 0; n < 2; ++n) _Pragma("unroll") for (int k = 0; k < 2; ++k) \
        acc[ai][bj][m][n] = SWAP ? __builtin_amdgcn_mfma_f32_16x16x32_bf16(At[m][k], Bt[n][k], acc[ai][bj][m][n], 0, 0, 0) : __builtin_amdgcn_mfma_f32_16x16x32_bf16(Bt[n][k], At[m][k], acc[ai][bj][m][n], 0, 0, 0); __builtin_amdgcn_s_setprio(0); } while (0)
#define PG8_WAIT_V(n) asm volatile("s_waitcnt vmcnt(" #n ")" ::: "memory")
#define PG8_WAIT_L(n) asm volatile("s_waitcnt lgkmcnt(" #n ")" ::: "memory")
#define PG8_BAR __builtin_amdgcn_s_barrier()
#define PG8_SCHED __builtin_amdgcn_sched_barrier(0)
    Unit cur, nxt; int ui = 0;
    if (!S.next(0, cur)) return;
    f32x4 acc[2][2][4][2];
#pragma unroll
    for (int a = 0; a < 2; ++a)
#pragma unroll
        for (int b = 0; b < 2; ++b)
#pragma unroll
            for (int m = 0; m < 4; ++m)
#pragma unroll
                for (int n = 0; n < 2; ++n) acc[a][b][m][n] = (f32x4){0.f, 0.f, 0.f, 0.f};
    bf16x8 At[4][2], B0[2][2], B1[2][2];
    const char* cA = (const char*)g.A + (size_t)cur.pm * tstep; const char* cB = (const char*)g.Bt + (size_t)cur.pn * tstep;
    S.a_ready(cur);
    if constexpr (SP2) {
        PG8_STAGE(PG8_SB(0, 0), cB, voffB); PG8_STAGE(PG8_SB(0, 1), cB + hstep, voffB); PG8_STAGE(PG8_SA(0, 0), cA, voffA); PG8_STAGE(PG8_SA(0, 1), cA + hstep, voffA);
        if (wr == 1) PG8_BAR;
        PG8_WAIT_V(2); PG8_BAR;
        PG8_STAGE(PG8_SB(1, 0), cB + kstep, voffB); PG8_STAGE(PG8_SA(1, 0), cA + kstep, voffA); PG8_STAGE(PG8_SB(1, 1), cB + hstep + kstep, voffB);
        PG8_WAIT_V(6); PG8_BAR;
    } else {
        PG8_STAGE(PG8_SB(0, 0), cB, voffB); PG8_STAGE(PG8_SA(0, 0), cA, voffA); PG8_STAGE(PG8_SB(0, 1), cB + hstep, voffB); PG8_STAGE(PG8_SA(0, 1), cA + hstep, voffA);
        if (wr == 1) PG8_BAR;
        PG8_WAIT_V(4); PG8_BAR;
        PG8_STAGE(PG8_SB(1, 0), cB + kstep, voffB); PG8_STAGE(PG8_SA(1, 0), cA + kstep, voffA); PG8_STAGE(PG8_SB(1, 1), cB + hstep + kstep, voffB);
        PG8_WAIT_V(6); PG8_BAR;
    }
    for (;;) {
        const bool has_next = S.next(ui + 1, nxt);
        const char* nA = has_next ? (const char*)g.A + (size_t)nxt.pm * tstep : cA; const char* nB = has_next ? (const char*)g.Bt + (size_t)nxt.pn * tstep : cB;
        for (int t = 0; t < nt; t += 2) {
            const bool last = (t == nt - 2);
            if constexpr (HOOK) { if (t == (nt >> 1)) E.mid(acc, cur, wr, wc, fr, fq); }
            const char* a1 = cA + (size_t)(t + 1) * kstep;
            const char* a2 = last ? nA : cA + (size_t)(t + 2) * kstep; const char* b2 = last ? nB : cB + (size_t)(t + 2) * kstep;
            const char* a3 = a2 + kstep; const char* b3 = b2 + kstep;
            if (last && has_next) S.a_ready(nxt);
            if constexpr (SP2) {
            PG8_LDB(B0, 0, 0); PG8_LDB(B1, 0, 1); PG8_SCHED; PG8_LDA(At, 0, 0); PG8_STAGE(PG8_SA(1, 1), a1 + hstep, voffA);
            PG8_WAIT_V(8); PG8_WAIT_L(0); PG8_BAR; PG8_MMA(0, 0, At, B0); PG8_MMA(0, 1, At, B1); PG8_BAR; PG8_SCHED;
            PG8_LDA(At, 0, 1); PG8_STAGE(PG8_SB(0, 0), b2, voffB); PG8_STAGE(PG8_SB(0, 1), b2 + hstep, voffB); PG8_STAGE(PG8_SA(0, 0), a2, voffA);
            PG8_WAIT_V(8); PG8_WAIT_L(0); PG8_BAR; PG8_MMA(1, 0, At, B0); PG8_MMA(1, 1, At, B1); PG8_BAR; PG8_SCHED;
            PG8_LDB(B0, 1, 0); PG8_LDB(B1, 1, 1); PG8_SCHED; PG8_LDA(At, 1, 0); PG8_STAGE(PG8_SA(0, 1), a2 + hstep, voffA);
            PG8_WAIT_V(8); PG8_WAIT_L(0); PG8_BAR; PG8_MMA(0, 0, At, B0); PG8_MMA(0, 1, At, B1); PG8_BAR; PG8_SCHED;
            PG8_LDA(At, 1, 1); PG8_STAGE(PG8_SB(1, 0), b3, voffB); PG8_STAGE(PG8_SB(1, 1), b3 + hstep, voffB); PG8_STAGE(PG8_SA(1, 0), a3, voffA);
            PG8_WAIT_V(8); PG8_WAIT_L(0); PG8_BAR; PG8_MMA(1, 0, At, B0); PG8_MMA(1, 1, At, B1); PG8_BAR; PG8_SCHED;
            } else {
            PG8_LDB(B0, 0, 0); PG8_SCHED; PG8_LDA(At, 0, 0); PG8_STAGE(PG8_SA(1, 1), a1 + hstep, voffA);
            PG8_WAIT_L(8); PG8_BAR; PG8_WAIT_L(0); PG8_MMA(0, 0, At, B0); PG8_BAR; PG8_SCHED;
            PG8_LDB(B1, 0, 1); PG8_STAGE(PG8_SB(0, 0), b2, voffB);
            PG8_BAR; PG8_WAIT_L(0); PG8_MMA(0, 1, At, B1); PG8_BAR;
            PG8_LDA(At, 0, 1); PG8_STAGE(PG8_SA(0, 0), a2, voffA);
            PG8_BAR; PG8_WAIT_L(0); PG8_MMA(1, 0, At, B0); PG8_BAR; PG8_SCHED;
            PG8_STAGE(PG8_SB(0, 1), b2 + hstep, voffB);
            PG8_WAIT_V(6); PG8_BAR; PG8_MMA(1, 1, At, B1); PG8_BAR;
            PG8_LDB(B0, 1, 0); PG8_SCHED; PG8_LDA(At, 1, 0); PG8_STAGE(PG8_SA(0, 1), a2 + hstep, voffA);
            PG8_WAIT_L(8); PG8_BAR; PG8_WAIT_L(0); PG8_MMA(0, 0, At, B0); PG8_BAR; PG8_SCHED;
            PG8_LDB(B1, 1, 1); PG8_STAGE(PG8_SB(1, 0), b3, voffB);
            PG8_BAR; PG8_WAIT_L(0); PG8_MMA(0, 1, At, B1); PG8_BAR;
            PG8_LDA(At, 1, 1); PG8_STAGE(PG8_SA(1, 0), a3, voffA);
            PG8_BAR; PG8_WAIT_L(0); PG8_MMA(1, 0, At, B0); PG8_BAR; PG8_SCHED;
            PG8_STAGE(PG8_SB(1, 1), b3 + hstep, voffB);
            PG8_WAIT_V(6); PG8_BAR; PG8_MMA(1, 1, At, B1); PG8_BAR;
            }
        }
        if constexpr (ALIGN_EPI) { if (wr == 0) PG8_BAR; }
        if constexpr (!Epi::AFTER_DRAIN) { E(acc, cur, wr, wc, fr, fq); S.done(cur); }
        if (!has_next) break;
#pragma unroll
        for (int a = 0; a < 2; ++a)
#pragma unroll
            for (int b = 0; b < 2; ++b)
#pragma unroll
                for (int m = 0; m < 4; ++m)
#pragma unroll
                    for (int n = 0; n < 2; ++n) acc[a][b][m][n] = (f32x4){0.f, 0.f, 0.f, 0.f};
        cur = nxt; cA = nA; cB = nB; ++ui;
        if constexpr (ALIGN_EPI) { if (wr == 1) PG8_BAR; }
    }
    PG8_WAIT_V(0);
    if constexpr (!ALIGN_EPI) { if (wr == 0) PG8_BAR; }
    PG8_BAR;
    if constexpr (Epi::AFTER_DRAIN) { E.fused(acc, cur, wr, wc, fr, fq, lds, wid, lane); S.done(cur); }
#undef PG8_SA
#undef PG8_SB
#undef PG8_STAGE
#undef PG8_LDA
#undef PG8_LDB
#undef PG8_MMA
#undef PG8_WAIT_V
#undef PG8_WAIT_L
#undef PG8_BAR
#undef PG8_SCHED
}
}

typedef unsigned short bf16_t;
typedef short bf16x8 __attribute__((ext_vector_type(8)));
typedef float f32x4 __attribute__((ext_vector_type(4)));
typedef unsigned u32x4 __attribute__((ext_vector_type(4)));
#define LAS __attribute__((address_space(3)))
constexpr int DM = 1024, SEQ = 8192, NB = 2, MTOK = NB * SEQ, CTX = 256, NH = 16, HD = 64, INC = 10240;
constexpr size_t MiB = 1u << 20;
constexpr size_t WS_MOD = 0, WS_SSQ = 65536, WS_ROPER = 131072, WS_ROPEC = 147456, WS_BAR = 196608, WS_CNT = 196608 + 16384, WS_BAR_BYTES = 32768, WS_XBUF = 524288, WS_BT = 1 * MiB, WS_WTIN = 6 * MiB, WS_HC = 26 * MiB, WS_KC = 27 * MiB, WS_VTC = 28 * MiB,
                 WS_EDGE = 29 * MiB, WS_H = 32 * MiB, WS_A2 = 64 * MiB, WS_W2T = 128 * MiB, WS_WOT = 132 * MiB, WS_KB = 160 * MiB, WS_MRG = 160 * MiB, WS_Y = 160 * MiB,
                 WS_VT = 192 * MiB, WS_SZB = 224 * MiB, WS_END = 256 * MiB;
constexpr int LDS_BYTES = 147456;
constexpr float LOG2E = 1.4426950408889634f;
constexpr float QSCALE = 0.125f * LOG2E;
constexpr int BT_VARS = 15, BT_BLKS = 9;

struct Params { const float* in[15]; float* out; unsigned char* ws; int flags; int pad; };

DI int perm32(int rho) { const int n = rho >> 4, i = rho & 15; return 8 * (i >> 2) + 4 * n + (i & 3); }
DI int swap23(int i) { return (i & 0x13) | ((i & 4) << 1) | ((i & 8) >> 1); }
DI int crow(int r, int hi) { return (r & 3) + 8 * (r >> 2) + 4 * hi; }
DI int iclip(int v, int lo, int hi) { return v < lo ? lo : (v > hi ? hi : v); }
DI float wave_sum(float v) {
#pragma unroll
    for (int o = 1; o < 64; o <<= 1) v += __shfl_xor(v, o);
    return v;
}
DI int wtin_src_col(int R) {
    if (R < 4096) { const int jt = R >> 8, q = R & 255, bj = q >> 7, wc = (q >> 5) & 3, n = (q >> 4) & 1, i = q & 15; return (2 * bj + n) * 1024 + 64 * jt + 16 * wc + i; }
    if (R < 6144) return R;
    if (R < 9216) return (R & ~31) + 1024 + perm32(R & 31);
    return R - 3072;
}

template <int CTRL> DI float dpp_keep(float oldv, float x) {
    return __builtin_bit_cast(float, __builtin_amdgcn_update_dpp(__builtin_bit_cast(int, oldv), __builtin_bit_cast(int, x), CTRL, 0xf, 0xf, false));
}
struct Epi1 {
    static constexpr bool AFTER_DRAIN = false;
    bf16_t *A2, *KB, *SZB, *SGA, *SGB; const float *roper, *ropec; const float *CW, *CBIAS; float* EDGE; LAS float* EX;
    DI void operator()(const f32x4 (&acc)[2][2][4][2], const pg8::Unit& u, int wr, int wc, int fr, int fq) const {
        const int row0 = u.pm * 256 + wr * 64 + fr;
        if (u.pn < 16) {
            const int ch = 64 * u.pn + 16 * wc + 4 * fq, cl = 16 * wc + 4 * fq;
            f32x4 cx[2][4];
#pragma unroll
            for (int ai = 0; ai < 2; ++ai)
#pragma unroll
                for (int m = 0; m < 4; ++m) cx[ai][m] = acc[ai][0][m][1] * acc[ai][1][m][0];
#pragma unroll
            for (int ai = 0; ai < 2; ++ai) { const int s = 2 * ai + wr;
                if (fr == 0) *(LAS f32x4*)(EX + s * 64 + cl) = cx[ai][0];
                if (fr == 15) *(LAS f32x4*)(EX + 256 + s * 64 + cl) = cx[ai][3]; }
            asm volatile("s_waitcnt lgkmcnt(0)" ::: "memory"); __builtin_amdgcn_s_barrier(); asm volatile("" ::: "memory");
            const f32x4 w0 = *(const f32x4*)(CW + ch), w1 = *(const f32x4*)(CW + 1024 + ch), w2 = *(const f32x4*)(CW + 2048 + ch), cb = *(const f32x4*)(CBIAS + ch);
            const f32x4 zero4 = {0.f, 0.f, 0.f, 0.f};
#pragma unroll
            for (int ai = 0; ai < 2; ++ai) { const int s = 2 * ai + wr;
                const f32x4 hup = s > 0 ? *(const LAS f32x4*)(EX + 256 + (s - 1) * 64 + cl) : zero4;
                const f32x4 hdn = s < 3 ? *(const LAS f32x4*)(EX + (s + 1) * 64 + cl) : zero4;
                u32x2 wq[4];
#pragma unroll
                for (int m = 0; m < 4; ++m) {
                    const f32x4 bg = acc[ai][0][m][0], za = acc[ai][1][m][1]; f32x4 gz, ua;
#pragma unroll
                    for (int j = 0; j < 4; ++j) {
                        gz[j] = fsilu(za[j]) * bg[j];
                        const float wu = m > 0 ? dpp_keep<0x10F>(0.f, cx[ai][m > 0 ? m - 1 : 0][j]) : hup[j];
                        const float up = dpp_keep<0x111>(wu, cx[ai][m][j]);
                        const float wd = m < 3 ? dpp_keep<0x11F>(0.f, cx[ai][m < 3 ? m + 1 : 3][j]) : hdn[j];
                        const float dn = dpp_keep<0x101>(wd, cx[ai][m][j]);
                        ua[j] = gz[j] * (w0[j] * up + w1[j] * cx[ai][m][j] + w2[j] * dn + cb[j]);
                    }
                    wq[m].x = pk2(ua[0], ua[1]); wq[m].y = pk2(ua[2], ua[3]);
                    if (ai == 0 && m == 0 && wr == 0 && fr == 0) { *(f32x4*)(EDGE + (size_t)(u.pm * 4 + 0) * 1024 + ch) = cx[0][0]; *(f32x4*)(EDGE + (size_t)(u.pm * 4 + 2) * 1024 + ch) = gz; }
                    if (ai == 1 && m == 3 && wr == 1 && fr == 15) { *(f32x4*)(EDGE + (size_t)(u.pm * 4 + 1) * 1024 + ch) = cx[1][3]; *(f32x4*)(EDGE + (size_t)(u.pm * 4 + 3) * 1024 + ch) = gz; }
                }
#pragma unroll
                for (int p = 0; p < 2; ++p) {
                    const auto s0 = __builtin_amdgcn_permlane16_swap(wq[2 * p].x, wq[2 * p + 1].x, false, false);
                    const auto s1 = __builtin_amdgcn_permlane16_swap(wq[2 * p].y, wq[2 * p + 1].y, false, false);
                    u32x4 o; o.x = s0[0]; o.y = s1[0]; o.z = s0[1]; o.w = s1[1];
                    *(u32x4*)(A2 + (size_t)(row0 + 128 * ai + 16 * (2 * p + (fq & 1))) * 2048 + 64 * u.pn + 16 * wc + 8 * (fq >> 1)) = o;
                }
            }
        } else if (u.pn < 24) {
            const bool isq = u.pn < 20;
            const int ct = (u.pn - (isq ? 16 : 20)) * 256;
            bf16_t* dst = isq ? (A2 + 1024) : KB; const size_t pitch = isq ? 2048 : 1024; const float sc = isq ? QSCALE : 1.0f;
            const int chunk = 4 * (wc & 1) + fq;
            bf16_t* pr = isq ? dst + (size_t)row0 * pitch + ct + 32 * wc + 8 * fq
                             : KB + (size_t)(u.pm >> 5) * 8388608 + (size_t)((u.pn - 20) * 4 + (wc >> 1)) * 524288 + (size_t)(4 * (u.pm & 31) + wr) * 4096
                                  + (fr >> 3) * 512 + (chunk >> 1) * 128 + (chunk & 1) * 64 + (fr & 7) * 8;
            const size_t sM = isq ? (size_t)16 * 2048 : 1024, sA = isq ? (size_t)64 * 2048 : (8192 - 4 * 1024), sB = isq ? 128 : 1048576;
#pragma unroll
            for (int ai = 0; ai < 2; ++ai) {
#pragma unroll
                for (int m = 0; m < 4; ++m) {
                    const int t = (row0 + 128 * ai + 16 * m) & (SEQ - 1);
                    const float* tab = (wc & 1) ? (ropec + (t & 63) * 32) : (roper + (t >> 6) * 32);
                    const f32x4 cs = *(const f32x4*)(tab + 4 * fq), sn = *(const f32x4*)(tab + 16 + 4 * fq);
                    asm volatile("" : "+v"(pr));
#pragma unroll
                    for (int bj = 0; bj < 2; ++bj) {
                        const f32x4 u1 = acc[ai][bj][m][0], u2 = acc[ai][bj][m][1];
                        const f32x4 o1 = (u1 * cs - u2 * sn) * sc, o2 = (u2 * cs + u1 * sn) * sc;
                        u32x4 w; w.x = pk2(o1[0], o1[1]); w.y = pk2(o1[2], o1[3]); w.z = pk2(o2[0], o2[1]); w.w = pk2(o2[2], o2[3]);
                        *(u32x4*)(pr + (bj ? sB : 0)) = w;
                    }
                    pr += sM;
                }
                pr += sA;
            }
        } else {
            const int ty = (u.pn - 24) >> 2;
            const int ct = ((u.pn - 24) & 3) * 256;
            int frl = fr, fql = fq; asm volatile("" : "+v"(frl), "+v"(fql));
            bf16_t* dst = SGA + (size_t)(ty == 2 ? 1 : 0) * ((size_t)MTOK * DM); if (ty == 0) dst = SZB;
#pragma unroll
            for (int ai = 0; ai < 2; ++ai)
#pragma unroll
                for (int m = 0; m < 4; ++m) {
                    const size_t row = (size_t)(row0 + 128 * ai + 16 * m);
#pragma unroll
                    for (int bj = 0; bj < 2; ++bj) {
                        f32x4 v0 = acc[ai][bj][m][0], v1 = acc[ai][bj][m][1];
                        if (ty == 0) {
#pragma unroll
                            for (int j = 0; j < 4; ++j) { v0[j] = fsilu(v0[j]); v1[j] = fsilu(v1[j]); }
                        } else {
#pragma unroll
                            for (int j = 0; j < 4; ++j) { v0[j] = fsigm(v0[j]); v1[j] = fsigm(v1[j]); }
                        }
                        u32x4 w; w.x = pk2(v0[0], v0[1]); w.y = pk2(v0[2], v0[3]); w.z = pk2(v1[0], v1[1]); w.w = pk2(v1[2], v1[3]);
                        if (ty == 0) *(u32x4*)(dst + row * 1024 + ct + 128 * bj + 32 * wc + 8 * fql) = w;
                        else *(u32x4*)(dst + (size_t)(u.pm * 4 + (ct >> 8)) * 65536 + ai * 32768 + m * 8192 + bj * 4096 + (wr * 4 + wc) * 512 + (fql * 16 + frl) * 8) = w;
                    }
                }
        }
    }
};
struct EpiV {
    static constexpr bool AFTER_DRAIN = false;
    bf16_t* VT;
    DI void operator()(const f32x4 (&acc)[2][2][4][2], const pg8::Unit& u, int wr, int wc, int fr, int fq) const {
        const int tok0 = u.pm * 256 + wr * 64 + 8 * fq;
#pragma unroll
        for (int bj = 0; bj < 2; ++bj)
#pragma unroll
            for (int n = 0; n < 2; ++n) {
                const int col = u.pn * 256 + 128 * bj + 32 * wc + 16 * n + fr;
#pragma unroll
                for (int ai = 0; ai < 2; ++ai)
#pragma unroll
                    for (int p = 0; p < 2; ++p) {
                        const int tok = tok0 + 128 * ai + 32 * p; const int b = tok >> 13, t = tok & (SEQ - 1);
                        const f32x4 v0 = acc[ai][bj][2 * p][n], v1 = acc[ai][bj][2 * p + 1][n];
                        u32x4 w; w.x = pk2(v0[0], v0[1]); w.y = pk2(v0[2], v0[3]); w.z = pk2(v1[0], v1[1]); w.w = pk2(v1[2], v1[3]);
                        *(u32x4*)(VT + (size_t)(b * NH + (col >> 6)) * 524288 + (size_t)(t >> 6) * 4096 + ((t & 63) >> 3) * 512 + (col & 63) * 8) = w;
                    }
            }
    }
};
struct Epi2 {
    static constexpr bool AFTER_DRAIN = false;
    const bf16_t *SGA, *SGB; bf16_t* MRG;
    DI void mid(f32x4 (&acc)[2][2][4][2], const pg8::Unit& u, int wr, int wc, int fr, int fq) const {
        const size_t img = (size_t)(u.pm * 4 + u.pn) * 65536 + (wr * 4 + wc) * 512 + (fq * 16 + fr) * 8;
#pragma unroll
        for (int ai = 0; ai < 2; ++ai) {
            const bf16_t* pa = SGA + img + (size_t)ai * 32768; const bf16_t* pb = SGB + img + (size_t)ai * 32768;
            asm volatile("" : "+v"(pa), "+v"(pb) :: "memory");
            u32x4 a[4][2], b[4][2];
#pragma unroll
            for (int m = 0; m < 4; ++m)
#pragma unroll
                for (int bj = 0; bj < 2; ++bj) { a[m][bj] = *(const u32x4*)(pa + m * 8192 + 4096 * bj); b[m][bj] = *(const u32x4*)(pb + m * 8192 + 4096 * bj); }
#pragma unroll
            for (int m = 0; m < 4; ++m)
#pragma unroll
                for (int bj = 0; bj < 2; ++bj) {
                    const u32x4 A = a[m][bj], B = b[m][bj]; f32x4 r0, r1;
                    r0[0] = bflo(A.x) * __builtin_amdgcn_rcpf(bflo(B.x)); r0[1] = bfhi(A.x) * __builtin_amdgcn_rcpf(bfhi(B.x)); r0[2] = bflo(A.y) * __builtin_amdgcn_rcpf(bflo(B.y)); r0[3] = bfhi(A.y) * __builtin_amdgcn_rcpf(bfhi(B.y));
                    r1[0] = bflo(A.z) * __builtin_amdgcn_rcpf(bflo(B.z)); r1[1] = bfhi(A.z) * __builtin_amdgcn_rcpf(bfhi(B.z)); r1[2] = bflo(A.w) * __builtin_amdgcn_rcpf(bflo(B.w)); r1[3] = bfhi(A.w) * __builtin_amdgcn_rcpf(bfhi(B.w));
                    acc[ai][bj][m][0] *= r0; acc[ai][bj][m][1] *= r1;
                }
            asm volatile("" ::: "memory");
        }
    }
    DI void operator()(const f32x4 (&acc)[2][2][4][2], const pg8::Unit& u, int wr, int wc, int fr, int fq) const {
        const size_t base = (size_t)(u.pm * 256 + wr * 64 + fr) * 1024 + u.pn * 256 + 32 * wc + 8 * fq;
        const size_t img = (size_t)(u.pm * 4 + u.pn) * 65536 + (wr * 4 + wc) * 512 + (fq * 16 + fr) * 8;
#pragma unroll
        for (int ai = 0; ai < 2; ++ai) {
            const bf16_t* pb = SGB + img + (size_t)ai * 32768; bf16_t* po = MRG + base + (size_t)ai * (128 * 1024);
            asm volatile("" : "+v"(pb), "+v"(po) :: "memory");
            u32x4 b[4][2];
#pragma unroll
            for (int m = 0; m < 4; ++m)
#pragma unroll
                for (int bj = 0; bj < 2; ++bj) b[m][bj] = *(const u32x4*)(pb + m * 8192 + 4096 * bj);
#pragma unroll
            for (int m = 0; m < 4; ++m)
#pragma unroll
                for (int bj = 0; bj < 2; ++bj) {
                    const u32x4 B = b[m][bj]; const f32x4 v0 = acc[ai][bj][m][0], v1 = acc[ai][bj][m][1];
                    u32x4 w; w.x = pk2(v0[0] * bflo(B.x), v0[1] * bfhi(B.x)); w.y = pk2(v0[2] * bflo(B.y), v0[3] * bfhi(B.y));
                    w.z = pk2(v1[0] * bflo(B.z), v1[1] * bfhi(B.z)); w.w = pk2(v1[2] * bflo(B.w), v1[3] * bfhi(B.w));
                    *(u32x4*)(po + m * (16 * 1024) + 128 * bj) = w;
                }
            asm volatile("" ::: "memory");
        }
    }
};
struct Epi3 {
    static constexpr bool AFTER_DRAIN = false;
    float* Y; float* SSQ;
    DI void operator()(const f32x4 (&acc)[2][2][4][2], const pg8::Unit& u, int wr, int wc, int fr, int fq) const {
        const int row0 = u.pm * 256 + wr * 64 + fr, col0 = u.pn * 256 + 32 * wc + 8 * fq;
#pragma unroll
        for (int ai = 0; ai < 2; ++ai)
#pragma unroll
            for (int m = 0; m < 4; ++m) {
                const int row = row0 + 128 * ai + 16 * m; float s = 0.f;
#pragma unroll
                for (int bj = 0; bj < 2; ++bj) {
                    const f32x4 v0 = acc[ai][bj][m][0], v1 = acc[ai][bj][m][1];
                    float* p = Y + (size_t)row * 1024 + col0 + 128 * bj;
                    *(f32x4*)p = v0; *(f32x4*)(p + 4) = v1;
                    s += (v0[0] * v0[0] + v0[1] * v0[1]) + (v0[2] * v0[2] + v0[3] * v0[3]) + (v1[0] * v1[0] + v1[1] * v1[1]) + (v1[2] * v1[2] + v1[3] * v1[3]);
                }
                s += __shfl_xor(s, 16); s += __shfl_xor(s, 32);
                if (fq == 0) atomicAdd(SSQ + row, s);
            }
    }
};

struct EpiOut {
    static constexpr bool AFTER_DRAIN = true;
    const float* X; float* OUT; const float* MOD; const float* PG; float* xbuf; unsigned* cnt;
    DI void operator()(const f32x4 (&)[2][2][4][2], const pg8::Unit&, int, int, int, int) const {}
    DI void fused(f32x4 (&acc)[2][2][4][2], const pg8::Unit& u, int wr, int wc, int fr, int fq, LAS unsigned char* lds, int wid, int lane) const {
        LAS float* Pp = (LAS float*)lds;
        LAS float* Sr = (LAS float*)(lds + 4096);
        const int tid = wid * 64 + lane;
        const int row0 = u.pm * 256 + wr * 64 + fr, col0 = u.pn * 256 + 32 * wc + 8 * fq;
#pragma unroll
        for (int ai = 0; ai < 2; ++ai)
#pragma unroll
            for (int m = 0; m < 4; ++m) {
                float s = 0.f;
#pragma unroll
                for (int bj = 0; bj < 2; ++bj)
#pragma unroll
                    for (int n = 0; n < 2; ++n) { const f32x4 v = acc[ai][bj][m][n]; s += (v[0] * v[0] + v[1] * v[1]) + (v[2] * v[2] + v[3] * v[3]); }
                s += __shfl_xor(s, 16); s += __shfl_xor(s, 32);
                if (fq == 0) Pp[(ai * 128 + wr * 64 + m * 16 + fr) * 4 + wc] = s;
            }
        asm volatile("s_waitcnt lgkmcnt(0)" ::: "memory"); __builtin_amdgcn_s_barrier(); asm volatile("" ::: "memory");
        {
            const float* gt = MOD + (u.pm >> 5) * 3072 + 2048;
#pragma unroll
            for (int bj = 0; bj < 2; ++bj)
#pragma unroll
                for (int n = 0; n < 2; ++n) { const f32x4 gpv = *(const f32x4*)(gt + col0 + 128 * bj + 4 * n) * *(const f32x4*)(PG + col0 + 128 * bj + 4 * n);
#pragma unroll
                    for (int ai = 0; ai < 2; ++ai)
#pragma unroll
                        for (int m = 0; m < 4; ++m) acc[ai][bj][m][n] *= gpv; }
        }
        f32x4 preA[2][2][2], preB[2][2][2];
#define EPO_LOAD(pre, ai_, mp_) do { _Pragma("unroll") for (int mm = 0; mm < 2; ++mm) _Pragma("unroll") for (int bj = 0; bj < 2; ++bj) { \
            const float* p_ = X + (size_t)(row0 + 128 * (ai_) + 16 * (2 * (mp_) + mm)) * 1024 + col0 + 128 * bj; pre[mm][bj][0] = *(const f32x4*)p_; pre[mm][bj][1] = *(const f32x4*)(p_ + 4); } } while (0)
#define EPO_STORE(pre, ai_, mp_) do { _Pragma("unroll") for (int mm = 0; mm < 2; ++mm) { const int m_ = 2 * (mp_) + mm; const float rs_ = Sr[128 * (ai_) + wr * 64 + m_ * 16 + fr]; \
            _Pragma("unroll") for (int bj = 0; bj < 2; ++bj) { float* o_ = OUT + (size_t)(row0 + 128 * (ai_) + 16 * m_) * 1024 + col0 + 128 * bj; \
                *(f32x4*)o_ = pre[mm][bj][0] + acc[ai_][bj][m_][0] * rs_; *(f32x4*)(o_ + 4) = pre[mm][bj][1] + acc[ai_][bj][m_][1] * rs_; } } \
            asm volatile("" ::: "memory"); } while (0)
        EPO_LOAD(preA, 0, 0);
        if (tid < 256) { const float s = (Pp[tid * 4] + Pp[tid * 4 + 1]) + (Pp[tid * 4 + 2] + Pp[tid * 4 + 3]);
            __hip_atomic_store(xbuf + (size_t)((u.pm * 4 + u.pn) * 256 + tid), s, __ATOMIC_RELAXED, __HIP_MEMORY_SCOPE_AGENT); }
        asm volatile("s_waitcnt vmcnt(0)" ::: "memory");
        if (wid < 4 && lane == 0) __hip_atomic_fetch_add(cnt + 64 * u.pm, 1u, __ATOMIC_RELAXED, __HIP_MEMORY_SCOPE_AGENT);
        if (wid == 0) {
            unsigned sp = 0;
            while ((unsigned)__builtin_amdgcn_readfirstlane(__hip_atomic_load(cnt + 64 * u.pm, __ATOMIC_RELAXED, __HIP_MEMORY_SCOPE_AGENT)) < 16u) { __builtin_amdgcn_s_sleep(2); if (++sp > (1u << 22)) break; }
            __builtin_amdgcn_fence(__ATOMIC_ACQUIRE, "agent");
        }
        asm volatile("s_waitcnt vmcnt(0) lgkmcnt(0)" ::: "memory"); __builtin_amdgcn_s_barrier(); asm volatile("" ::: "memory");
        if (tid < 256) { float t = 0.f;
#pragma unroll
            for (int p = 0; p < 4; ++p) t += __hip_atomic_load(xbuf + (size_t)((u.pm * 4 + p) * 256 + tid), __ATOMIC_RELAXED, __HIP_MEMORY_SCOPE_AGENT);
            Sr[tid] = 1.0f / sqrtf(t * (1.0f / 1024.0f) + 1e-6f); }
        asm volatile("s_waitcnt vmcnt(0) lgkmcnt(0)" ::: "memory"); __builtin_amdgcn_s_barrier(); asm volatile("" ::: "memory");
        EPO_LOAD(preB, 0, 1); EPO_STORE(preA, 0, 0); EPO_LOAD(preA, 1, 0); EPO_STORE(preB, 0, 1); EPO_LOAD(preB, 1, 1); EPO_STORE(preA, 1, 0); EPO_STORE(preB, 1, 1);
#undef EPO_LOAD
#undef EPO_STORE
    }
};

DI void transpose_item(const float* W, int ldw, int k0, int srccol4, bf16_t* WT, int ldk, int kd0, int drow0, LAS float* scr, int lane) {
    f32x4 tv[8];
    const int ng = lane & 7, kr = lane >> 3;
    const float* wp = W + (size_t)(k0 + kr) * ldw + srccol4;
#pragma unroll
    for (int i = 0; i < 8; ++i) tv[i] = __builtin_nontemporal_load((const f32x4*)(wp + (size_t)(8 * i) * ldw));
#pragma unroll
    for (int i = 0; i < 8; ++i) { LAS float* d = scr + (kr + 8 * i) * 33 + 4 * ng; d[0] = tv[i][0]; d[1] = tv[i][1]; d[2] = tv[i][2]; d[3] = tv[i][3]; }
    asm volatile("s_waitcnt lgkmcnt(0)" ::: "memory");
    const int c = lane & 7;
#pragma unroll
    for (int j = 0; j < 4; ++j) {
        const int n = (lane >> 3) + 8 * j; const LAS float* s = scr + (8 * c) * 33 + n;
        u32x4 o; o.x = pk2(s[0 * 33], s[1 * 33]); o.y = pk2(s[2 * 33], s[3 * 33]); o.z = pk2(s[4 * 33], s[5 * 33]); o.w = pk2(s[6 * 33], s[7 * 33]);
        *(u32x4*)(WT + (size_t)(drow0 + n) * ldk + kd0 + 8 * c) = o;
    }
    asm volatile("s_waitcnt lgkmcnt(0)" ::: "memory");
}

DI void phase0(const Params& P, LAS unsigned char* lds) {
    const int tid = threadIdx.x, lane = tid & 63, wave = __builtin_amdgcn_readfirstlane(tid >> 6), bx = blockIdx.x;
    const int gw = bx * 8 + wave, NGW = gridDim.x * 8, gtid = bx * 512 + tid, NT = gridDim.x * 512;
    unsigned char* ws = P.ws;
    for (int i = gtid; i < 64; i += NT) ((unsigned*)(ws + WS_CNT))[64 * i] = 0u;
    float* roper = (float*)(ws + WS_ROPER); float* ropec = (float*)(ws + WS_ROPEC);
    for (int i = gtid; i < (128 + 64) * 16; i += NT) {
        const int pos = i >> 4, f = i & 15; const float inv = powf(10000.0f, -(float)(2 * f) / 32.0f);
        if (pos < 128) { const float ang = (float)pos * inv; roper[pos * 32 + f] = cosf(ang); roper[pos * 32 + 16 + f] = sinf(ang); }
        else { const int p = pos - 128; const float ang = (float)p * inv; ropec[p * 32 + f] = cosf(ang); ropec[p * 32 + 16 + f] = sinf(ang); }
    }
    {
        bf16_t* BT = (bf16_t*)(ws + WS_BT); const float* rpb = P.in[11];
        const int total8 = NH * BT_VARS * BT_BLKS * 128;
        for (int e8 = gtid; e8 < total8; e8 += NT) {
            const int ln = e8 & 63, half = (e8 >> 6) & 1, rest = e8 >> 7, blk = rest % BT_BLKS, rest2 = rest / BT_BLKS, var = rest2 % BT_VARS, h = rest2 / BT_VARS;
            const int qi = ln & 31, hi = ln >> 5;
            const int rv = var / 3, cv = var % 3;
            const int r0 = rv == 0 ? 0 : (rv == 1 ? 2 : (rv == 2 ? 4 : (rv == 3 ? 124 : 126)));
            const int cbv = cv == 0 ? 0 : (cv == 1 ? 1 : 3), kc0 = cv == 0 ? 0 : (cv == 1 ? 8 : 32);
            const int rq = r0 + (qi >> 4), c = 16 * cbv + (qi & 15);
            const int rs0 = iclip(r0 - 4, 0, 120), rsq = iclip(rq - 4, 0, 120), kr = rs0 + blk, cs = iclip(c - 8, 0, 48);
            const bool rowok = (kr >= rsq) && (kr < rsq + 8);
            const float* rp = rpb + (h * 15 + (rowok ? kr - rq + 7 : 0)) * 31 - c + 15;
            float v[8];
#pragma unroll
            for (int i = 0; i < 8; ++i) { const int kc = kc0 + swap23(crow(8 * half + i, hi)); const bool valid = rowok && (kc >= cs) && (kc < cs + 16); const float t = rp[valid ? kc : c] * LOG2E; v[i] = valid ? t : -1.0e30f; }
            u32x4 o; o.x = pk2(v[0], v[1]); o.y = pk2(v[2], v[3]); o.z = pk2(v[4], v[5]); o.w = pk2(v[6], v[7]);
            *(u32x4*)(BT + (size_t)e8 * 8) = o;
        }
    }
    if (bx < 96) {
        LAS float* s = (LAS float*)lds;
        for (int i = tid; i < 3072; i += 512) { const int v = i >> 10, k = i & 1023; const float x = v < 2 ? P.in[1][v * 1024 + k] : P.in[3][k]; s[i] = x / (1.0f + expf(-x)); }
        __syncthreads();
        const float* wm = P.in[4]; const int col = bx * 32 + (lane & 31), rsub = lane >> 5;
        float a0 = 0.f, a1 = 0.f, a2 = 0.f;
#pragma unroll 16
        for (int it = 0; it < 64; ++it) { const int k = wave * 128 + it * 2 + rsub; const float w = wm[(size_t)k * 3072 + col]; a0 += s[k] * w; a1 += s[1024 + k] * w; a2 += s[2048 + k] * w; }
        a0 += __shfl_xor(a0, 32); a1 += __shfl_xor(a1, 32); a2 += __shfl_xor(a2, 32);
        LAS float* red = s + 3072;
        if (lane < 32) { red[(wave * 3 + 0) * 32 + lane] = a0; red[(wave * 3 + 1) * 32 + lane] = a1; red[(wave * 3 + 2) * 32 + lane] = a2; }
        __syncthreads();
        if (tid < 96) { const int v = tid >> 5, cl = tid & 31; float sum = 0.f;
#pragma unroll
            for (int w = 0; w < 8; ++w) sum += red[(w * 3 + v) * 32 + cl];
            ((float*)(ws + WS_MOD))[v * 3072 + bx * 32 + cl] = sum + P.in[5][bx * 32 + cl]; }
        __syncthreads();
    }
    {
        LAS float* scr = (LAS float*)(lds + wave * 16384);
        bf16_t* WT = (bf16_t*)(ws + WS_WTIN);
        for (int it = NGW - 1 - gw; it < 320 * 16; it += NGW) {
            const int G = it >> 4, kb = it & 15;
            transpose_item(P.in[8], INC, 64 * kb, wtin_src_col(32 * G + 4 * (lane & 7)), WT, 1024, 64 * kb, 32 * G, scr, lane);
        }
    }
}

DI void phase1(const Params& P) {
    const int tid = threadIdx.x, lane = tid & 63, wave = tid >> 6, gw = blockIdx.x * 8 + wave, NGW = gridDim.x * 8;
    unsigned char* ws = P.ws; const float* MOD = (const float*)(ws + WS_MOD); const float* g = P.in[6];
    const int NROW = MTOK;
    const bool xa = (gridDim.x == 256);
    const int rbase = xa ? 2048 * (int)(blockIdx.x & 7) + (int)(blockIdx.x >> 3) * 8 + wave : gw, rstep = xa ? 256 : NGW, nk = xa ? 8 : (NROW - gw + NGW - 1) / NGW;
    f32x4 xn[4], cA[4], cB[4]; int vcur = -1;
    if (nk > 0) { const f32x4* xr = (const f32x4*)(P.in[0] + (size_t)rbase * DM) + lane;
#pragma unroll
        for (int j = 0; j < 4; ++j) xn[j] = __builtin_nontemporal_load(xr + 64 * j); }
    for (int k = 0; k < nk; ++k) {
        const int m = rbase + rstep * k;
        bf16_t* dst = (bf16_t*)(ws + WS_H) + (size_t)m * DM; const int v = m >> 13;
        f32x4 x[4];
#pragma unroll
        for (int j = 0; j < 4; ++j) x[j] = xn[j];
        if (k + 1 < nk) { const f32x4* xr = (const f32x4*)(P.in[0] + (size_t)(m + rstep) * DM) + lane;
#pragma unroll
            for (int j = 0; j < 4; ++j) xn[j] = __builtin_nontemporal_load(xr + 64 * j); }
        float ss = 0.f;
#pragma unroll
        for (int j = 0; j < 4; ++j) ss += (x[j][0] * x[j][0] + x[j][1] * x[j][1]) + (x[j][2] * x[j][2] + x[j][3] * x[j][3]);
        const float rstd = 1.0f / sqrtf(wave_sum(ss) * (1.0f / DM) + 1e-6f);
        if (v != vcur) {
            vcur = v;
            const f32x4* sh = (const f32x4*)(MOD + v * 3072) + lane; const f32x4* sc = (const f32x4*)(MOD + v * 3072 + 1024) + lane; const f32x4* gg = (const f32x4*)g + lane;
#pragma unroll
            for (int j = 0; j < 4; ++j) { const f32x4 b = sc[64 * j], c = gg[64 * j]; cB[j] = sh[64 * j];
#pragma unroll
                for (int e = 0; e < 4; ++e) cA[j][e] = c[e] * (1.0f + b[e]); }
        }
        u32x2 w[4];
#pragma unroll
        for (int j = 0; j < 4; ++j) {
            f32x4 h;
#pragma unroll
            for (int e = 0; e < 4; ++e) h[e] = (x[j][e] * rstd) * cA[j][e] + cB[j][e];
            w[j].x = pk2(h[0], h[1]); w[j].y = pk2(h[2], h[3]);
        }
        const bool odd = (lane & 1) != 0;
#pragma unroll
        for (int p = 0; p < 2; ++p) {
            const unsigned sx = odd ? w[2 * p].x : w[2 * p + 1].x, sy = odd ? w[2 * p].y : w[2 * p + 1].y;
            const unsigned rx = (unsigned)__builtin_amdgcn_mov_dpp((int)sx, 0xB1, 0xf, 0xf, true), ry = (unsigned)__builtin_amdgcn_mov_dpp((int)sy, 0xB1, 0xf, 0xf, true);
            u32x4 o4;
            if (odd) { o4.x = rx; o4.y = ry; o4.z = w[2 * p + 1].x; o4.w = w[2 * p + 1].y; } else { o4.x = w[2 * p].x; o4.y = w[2 * p].y; o4.z = rx; o4.w = ry; }
            *(u32x4*)(dst + 4 * ((lane & ~1) + 64 * (2 * p + (odd ? 1 : 0)))) = o4;
        }
    }
}

DI void ctx_kv(const Params& P, LAS unsigned char* lds) {
    const int tid = threadIdx.x, lane = tid & 63, wave = __builtin_amdgcn_readfirstlane(tid >> 6), bx = blockIdx.x;
    unsigned char* ws = P.ws;
    const bf16_t* WT = (const bf16_t*)(ws + WS_WTIN); const float* MOD = (const float*)(ws + WS_MOD) + 2 * 3072; const float* g = P.in[6];
    bf16_t* KC = (bf16_t*)(ws + WS_KC); bf16_t* VTC = (bf16_t*)(ws + WS_VTC);
    const int r = lane & 31, hi = lane >> 5;
    constexpr int HROW = 2064;
    for (int blk = bx; blk < 256; blk += gridDim.x) {
        const int rb = blk >> 4, cbk = (blk & 15) * 4 + (wave & 3), kh = wave >> 2;
        const int wrow = (cbk < 32 ? 5120 : 9216 - 1024) + 32 * cbk + r;
        const bf16_t* bp = WT + (size_t)wrow * DM + kh * 512 + 8 * hi;
        bf16x8 Bf[32];
#pragma unroll
        for (int k = 0; k < 32; ++k) Bf[k] = *(const bf16x8*)(bp + 16 * k);
        f32x4 xa[4][4];
#pragma unroll
        for (int rr = 0; rr < 4; ++rr) { const f32x4* xr = (const f32x4*)(P.in[2] + (size_t)(32 * rb + 4 * wave + rr) * DM) + lane;
#pragma unroll
            for (int j = 0; j < 4; ++j) xa[rr][j] = xr[64 * j]; }
#pragma unroll
        for (int rr = 0; rr < 4; ++rr) {
            const int row = 4 * wave + rr;
            f32x4 x[4]; float ss = 0.f;
#pragma unroll
            for (int j = 0; j < 4; ++j) { x[j] = xa[rr][j]; ss += (x[j][0] * x[j][0] + x[j][1] * x[j][1]) + (x[j][2] * x[j][2] + x[j][3] * x[j][3]); }
            const float rstd = 1.0f / sqrtf(wave_sum(ss) * (1.0f / DM) + 1e-6f);
            const f32x4* sh = (const f32x4*)MOD + lane; const f32x4* sc = (const f32x4*)(MOD + 1024) + lane; const f32x4* gg = (const f32x4*)g + lane;
#pragma unroll
            for (int j = 0; j < 4; ++j) {
                const f32x4 a = sh[64 * j], b = sc[64 * j], c = gg[64 * j]; f32x4 h;
#pragma unroll
                for (int e = 0; e < 4; ++e) h[e] = (x[j][e] * rstd) * c[e] * (1.0f + b[e]) + a[e];
                u32x2 w; w.x = pk2(h[0], h[1]); w.y = pk2(h[2], h[3]);
                *(LAS u32x2*)(lds + row * HROW + (lane + 64 * j) * 8) = w;
            }
        }
        __syncthreads();
        const LAS unsigned char* ap = lds + r * HROW + (kh * 512 + 8 * hi) * 2;
        f32x16 acc = {0.f, 0.f, 0.f, 0.f, 0.f, 0.f, 0.f, 0.f, 0.f, 0.f, 0.f, 0.f, 0.f, 0.f, 0.f, 0.f};
#pragma unroll
        for (int k = 0; k < 32; ++k) {
            const bf16x8 a = *(const LAS bf16x8*)(ap + 32 * k);
            acc = __builtin_amdgcn_mfma_f32_32x32x16_bf16(a, Bf[k], acc, 0, 0, 0);
        }
        LAS float* red = (LAS float*)(lds + 32 * HROW) + ((wave & 3) * 64 + lane) * 16;
        if (kh == 1) {
#pragma unroll
            for (int i = 0; i < 16; ++i) red[i] = acc[i];
        }
        __syncthreads();
        if (kh == 0) {
#pragma unroll
            for (int i = 0; i < 16; ++i) acc[i] += red[i];
            if (cbk < 32) {
                const int c = 32 * cbk + r, head = c >> 6, d = c & 63, e = d & 31, pos = (d & 32) + 8 * ((e & 15) >> 2) + 4 * (e >> 4) + (e & 3);
#pragma unroll
                for (int i = 0; i < 16; ++i) { const int row = 32 * rb + crow(i, hi); KC[(size_t)row * DM + head * 64 + pos] = (bf16_t)(pk2(acc[i], 0.f) & 0xffffu); }
            } else {
                const int c = 32 * (cbk - 32) + r;
#pragma unroll
                for (int g2 = 0; g2 < 4; ++g2) {
                    const int row = 32 * rb + 8 * g2 + 4 * hi; const int b = row >> 8, key = row & 255;
                    u32x2 w; w.x = pk2(acc[4 * g2], acc[4 * g2 + 1]); w.y = pk2(acc[4 * g2 + 2], acc[4 * g2 + 3]);
                    *(u32x2*)(VTC + ((size_t)(b * 1024 + c)) * CTX + key) = w;
                }
            }
        }
        __syncthreads();
    }
}

DI void softmax_step(f32x16& S, float& mrun, float& lrun, f32x16 (&O)[2], bf16x8 (&Pf)[2]) {
    float bm = fmaxf(fmaxf(S[0], S[1]), fmaxf(S[2], S[3]));
#pragma unroll
    for (int r = 4; r < 16; r += 4) bm = fmaxf(bm, fmaxf(fmaxf(S[r], S[r + 1]), fmaxf(S[r + 2], S[r + 3])));
    bm = fmaxf(bm, __shfl_xor(bm, 32));
    if (__any(bm > mrun + 8.0f)) {
        const float mn = fmaxf(mrun, bm), alpha = __builtin_amdgcn_exp2f(mrun - mn);
        lrun *= alpha; mrun = mn;
#pragma unroll
        for (int r = 0; r < 16; ++r) { O[0][r] *= alpha; O[1][r] *= alpha; }
    }
    float ls0 = 0.f, ls1 = 0.f;
#pragma unroll
    for (int r = 0; r < 16; r += 2) { S[r] = __builtin_amdgcn_exp2f(S[r] - mrun); S[r + 1] = __builtin_amdgcn_exp2f(S[r + 1] - mrun); ls0 += S[r]; ls1 += S[r + 1]; }
    lrun += ls0 + ls1;
#pragma unroll
    for (int s = 0; s < 2; ++s) {
        u32x4 p; p.x = pk2(S[8 * s], S[8 * s + 1]); p.y = pk2(S[8 * s + 2], S[8 * s + 3]); p.z = pk2(S[8 * s + 4], S[8 * s + 5]); p.w = pk2(S[8 * s + 6], S[8 * s + 7]);
        Pf[s] = __builtin_bit_cast(bf16x8, p);
    }
}
DI void softmax_step2(f32x16& S0, f32x16& S1, float& mrun, float& lrun, f32x16 (&O)[2], bf16x8 (&P0)[2], bf16x8 (&P1)[2]) {
    float bm = fmaxf(fmaxf(S0[0], S0[1]), fmaxf(S1[0], S1[1]));
#pragma unroll
    for (int r = 2; r < 16; r += 2) bm = fmaxf(bm, fmaxf(fmaxf(S0[r], S0[r + 1]), fmaxf(S1[r], S1[r + 1])));
    bm = fmaxf(bm, __shfl_xor(bm, 32));
    if (__any(bm > mrun + 8.0f)) {
        const float mn = fmaxf(mrun, bm), alpha = __builtin_amdgcn_exp2f(mrun - mn);
        lrun *= alpha; mrun = mn;
#pragma unroll
        for (int r = 0; r < 16; ++r) { O[0][r] *= alpha; O[1][r] *= alpha; }
    }
    float ls0 = 0.f, ls1 = 0.f;
#pragma unroll
    for (int r = 0; r < 16; ++r) { S0[r] = __builtin_amdgcn_exp2f(S0[r] - mrun); S1[r] = __builtin_amdgcn_exp2f(S1[r] - mrun); ls0 += S0[r]; ls1 += S1[r]; }
    lrun += ls0 + ls1;
#pragma unroll
    for (int s = 0; s < 2; ++s) {
        u32x4 p; p.x = pk2(S0[8 * s], S0[8 * s + 1]); p.y = pk2(S0[8 * s + 2], S0[8 * s + 3]); p.z = pk2(S0[8 * s + 4], S0[8 * s + 5]); p.w = pk2(S0[8 * s + 6], S0[8 * s + 7]);
        P0[s] = __builtin_bit_cast(bf16x8, p);
        u32x4 q; q.x = pk2(S1[8 * s], S1[8 * s + 1]); q.y = pk2(S1[8 * s + 2], S1[8 * s + 3]); q.z = pk2(S1[8 * s + 4], S1[8 * s + 5]); q.w = pk2(S1[8 * s + 6], S1[8 * s + 7]);
        P1[s] = __builtin_bit_cast(bf16x8, q);
    }
}
constexpr int AT_KCS = 0, AT_KROW = 144, AT_VCS = 36864, AT_VROW = 528, AT_BTS = 70656;
DI void attn_phase(const Params& P, LAS unsigned char* lds, const bool do_store) {
    const int tid = threadIdx.x, lane = tid & 63, wave = tid >> 6, bx = blockIdx.x, G = gridDim.x;
    unsigned char* ws = P.ws;
    bf16_t* A2 = (bf16_t*)(ws + WS_A2); const bf16_t* KB = (const bf16_t*)(ws + WS_KB); const bf16_t* VT = (const bf16_t*)(ws + WS_VT);
    const bf16_t* KC = (const bf16_t*)(ws + WS_KC); const bf16_t* VTC = (const bf16_t*)(ws + WS_VTC); const bf16_t* SZB = (const bf16_t*)(ws + WS_SZB);
    const bf16_t* BT = (const bf16_t*)(ws + WS_BT);
    const int vcu = (G % 8 == 0) ? (bx % 8) * (G / 8) + bx / 8 : bx;
    const int qi = lane & 31, hi = lane >> 5, kperm = swap23(qi);
    for (int bi = vcu; bi < 256; bi += G) {
        const int rhalf = bi & 1, cb = (bi >> 1) & 3, bh = bi >> 3, b = bh >> 4, h = bh & 15;
        const int c0 = 16 * cb, kc0 = cb == 0 ? 0 : (cb == 1 ? 8 : (cb == 2 ? 24 : 32)), cv = cb == 0 ? 0 : (cb == 3 ? 2 : 1);
        {
            const bf16_t* ksrc = KC + (size_t)(b * CTX) * DM + h * 64;
#pragma unroll
            for (int i = 0; i < 4; ++i) { const int c = tid + 512 * i, row = c >> 3, ch = c & 7;
                *(LAS u32x4*)(lds + AT_KCS + row * AT_KROW + ch * 16) = *(const u32x4*)(ksrc + (size_t)row * DM + ch * 8); }
            const bf16_t* vsrc = VTC + (size_t)((b * NH + h) * 64) * CTX;
#pragma unroll
            for (int i = 0; i < 4; ++i) { const int c = tid + 512 * i, row = c >> 5, ch = c & 31;
                *(LAS u32x4*)(lds + AT_VCS + row * AT_VROW + ch * 16) = *(const u32x4*)(vsrc + (size_t)row * CTX + ch * 8); }
            const bf16_t* bsrc = BT + ((size_t)((h * BT_VARS + 6 + cv) * BT_BLKS)) * 1024;
            for (int c = tid; c < 1152; c += 512) {
                const u32x4 v = *(const u32x4*)(bsrc + c * 8);
                const int kbq = c >> 7, half = (c >> 6) & 1, ln = c & 63;
                LAS float* d = (LAS float*)(lds + AT_BTS + kbq * 4096 + (2 * half) * 1024 + ln * 16);
                f32x4 lo4 = {bflo(v.x), bfhi(v.x), bflo(v.y), bfhi(v.y)}, hi4 = {bflo(v.z), bfhi(v.z), bflo(v.w), bfhi(v.w)};
                *(LAS f32x4*)d = lo4; *(LAS f32x4*)(d + 256) = hi4;
            }
        }
        __syncthreads();
        const LAS unsigned char* kcl = lds + AT_KCS + kperm * AT_KROW + 16 * hi;
        const LAS unsigned char* vcl = lds + AT_VCS + qi * AT_VROW + 16 * hi;
        const LAS unsigned char* btl = lds + AT_BTS + lane * 16;
#pragma unroll 1
        for (int j = 0; j < 4; ++j) {
            const int rp = rhalf * 32 + wave + 8 * j, r0 = 2 * rp, rs0 = iclip(r0 - 4, 0, 120);
            const int rv = r0 == 0 ? 0 : (r0 == 2 ? 1 : (r0 == 124 ? 3 : (r0 == 126 ? 4 : 2)));
            const int tq = (r0 + (qi >> 4)) * 64 + c0 + (qi & 15);
            const size_t qoff = ((size_t)(b * SEQ + tq)) * 2048 + 1024 + h * 64;
            bf16x8 Qf[4];
#pragma unroll
            for (int d0 = 0; d0 < 4; ++d0) Qf[d0] = *(const bf16x8*)(A2 + qoff + 16 * d0 + 8 * hi);
            const bf16_t* knp = KB + (size_t)(b * NH + h) * 524288 + ((kc0 + kperm) >> 3) * 512 + hi * 64 + ((kc0 + kperm) & 7) * 8;
            const bf16_t* vnp = VT + (size_t)(b * NH + h) * 524288 + ((kc0 >> 3) + hi) * 512 + qi * 8;
            const bf16_t* btg = BT + ((size_t)((h * BT_VARS + rv * 3 + cv) * BT_BLKS)) * 1024 + lane * 8;
            bf16x8 Kn[4], Kn2[4], Vn[4];
            {
                const int krow = rs0, krow1 = min(rs0 + 1, 127);
#pragma unroll
                for (int d0 = 0; d0 < 4; ++d0) { Kn[d0] = *(const bf16x8*)(knp + (size_t)krow * 4096 + 128 * d0); Kn2[d0] = *(const bf16x8*)(knp + (size_t)krow1 * 4096 + 128 * d0); }
#pragma unroll
                for (int x = 0; x < 4; ++x) Vn[x] = *(const bf16x8*)(vnp + (size_t)krow * 4096 + 1024 * (x & 1) + 256 * (x >> 1));
            }
            f32x16 O[2];
#pragma unroll
            for (int r = 0; r < 16; ++r) { O[0][r] = 0.f; O[1][r] = 0.f; }
            float mrun = -1.0e30f, lrun = 0.f;
#pragma unroll 1
            for (int jp = 0; jp < 4; ++jp) {
                bf16x8 Ka[4], Kb[4];
#pragma unroll
                for (int d0 = 0; d0 < 4; ++d0) { Ka[d0] = *(const LAS bf16x8*)(kcl + (64 * jp) * AT_KROW + 32 * d0); Kb[d0] = *(const LAS bf16x8*)(kcl + (64 * jp + 32) * AT_KROW + 32 * d0); }
                f32x16 S0, S1;
#pragma unroll
                for (int r = 0; r < 16; ++r) { S0[r] = 0.f; S1[r] = 0.f; }
#pragma unroll
                for (int d0 = 0; d0 < 4; ++d0) { S0 = __builtin_amdgcn_mfma_f32_32x32x16_bf16(Ka[d0], Qf[d0], S0, 0, 0, 0); S1 = __builtin_amdgcn_mfma_f32_32x32x16_bf16(Kb[d0], Qf[d0], S1, 0, 0, 0); }
                bf16x8 Va[4], Vb[4];
#pragma unroll
                for (int x = 0; x < 4; ++x) { Va[x] = *(const LAS bf16x8*)(vcl + (32 * (x >> 1)) * AT_VROW + 128 * jp + 32 * (x & 1)); Vb[x] = *(const LAS bf16x8*)(vcl + (32 * (x >> 1)) * AT_VROW + 128 * jp + 64 + 32 * (x & 1)); }
                bf16x8 Pa[2], Pb[2];
                softmax_step2(S0, S1, mrun, lrun, O, Pa, Pb);
#pragma unroll
                for (int x = 0; x < 4; ++x) { O[x >> 1] = __builtin_amdgcn_mfma_f32_32x32x16_bf16(Va[x], Pa[x & 1], O[x >> 1], 0, 0, 0); O[x >> 1] = __builtin_amdgcn_mfma_f32_32x32x16_bf16(Vb[x], Pb[x & 1], O[x >> 1], 0, 0, 0); }
            }
            const bf16_t* zp = SZB + ((size_t)(b * SEQ + tq)) * DM + h * 64 + 4 * hi;
            u32x2 zz[8];
#pragma unroll
            for (int i = 0; i < 8; ++i) zz[i] = *(const u32x2*)(zp + 8 * i);
#pragma unroll
            for (int kb = 0; kb < 9; ++kb) {
                bf16x8 Kf[4], Vf[4];
#pragma unroll
                for (int d0 = 0; d0 < 4; ++d0) Kf[d0] = Kn[d0];
#pragma unroll
                for (int x = 0; x < 4; ++x) Vf[x] = Vn[x];
#pragma unroll
                for (int d0 = 0; d0 < 4; ++d0) Kn[d0] = Kn2[d0];
                if (kb < 7) {
                    const int krow2 = min(rs0 + kb + 2, 127);
#pragma unroll
                    for (int d0 = 0; d0 < 4; ++d0) Kn2[d0] = *(const bf16x8*)(knp + (size_t)krow2 * 4096 + 128 * d0);
                }
                if (kb < 8) {
                    const int krow = min(rs0 + kb + 1, 127);
#pragma unroll
                    for (int x = 0; x < 4; ++x) Vn[x] = *(const bf16x8*)(vnp + (size_t)krow * 4096 + 1024 * (x & 1) + 256 * (x >> 1));
                }
                f32x16 S;
                if (rv == 2) {
#pragma unroll
                    for (int q = 0; q < 4; ++q) { const f32x4 t4 = *(const LAS f32x4*)(btl + kb * 4096 + q * 1024); S[4 * q] = t4[0]; S[4 * q + 1] = t4[1]; S[4 * q + 2] = t4[2]; S[4 * q + 3] = t4[3]; }
                } else {
                    const u32x4 b0 = *(const u32x4*)(btg + kb * 1024), b1 = *(const u32x4*)(btg + kb * 1024 + 512);
                    S[0] = bflo(b0.x); S[1] = bfhi(b0.x); S[2] = bflo(b0.y); S[3] = bfhi(b0.y); S[4] = bflo(b0.z); S[5] = bfhi(b0.z); S[6] = bflo(b0.w); S[7] = bfhi(b0.w);
                    S[8] = bflo(b1.x); S[9] = bfhi(b1.x); S[10] = bflo(b1.y); S[11] = bfhi(b1.y); S[12] = bflo(b1.z); S[13] = bfhi(b1.z); S[14] = bflo(b1.w); S[15] = bfhi(b1.w);
                }
#pragma unroll
                for (int d0 = 0; d0 < 4; ++d0) S = __builtin_amdgcn_mfma_f32_32x32x16_bf16(Kf[d0], Qf[d0], S, 0, 0, 0);
                bf16x8 Pf[2];
                softmax_step(S, mrun, lrun, O, Pf);
#pragma unroll
                for (int x = 0; x < 4; ++x) O[x >> 1] = __builtin_amdgcn_mfma_f32_32x32x16_bf16(Vf[x], Pf[x & 1], O[x >> 1], 0, 0, 0);
            }
            const float ltot = lrun + __shfl_xor(lrun, 32), inv = 1.0f / ltot;
            bf16_t* op = A2 + qoff + 8 * hi;
#pragma unroll
            for (int blk = 0; blk < 2; ++blk)
#pragma unroll
                for (int gp = 0; gp < 2; ++gp) {
                    u32x2 w[2];
#pragma unroll
                    for (int q = 0; q < 2; ++q) { const int g = 2 * gp + q; const u32x2 z = zz[4 * blk + g];
                        w[q].x = pk2(O[blk][4 * g] * inv * bflo(z.x), O[blk][4 * g + 1] * inv * bfhi(z.x)); w[q].y = pk2(O[blk][4 * g + 2] * inv * bflo(z.y), O[blk][4 * g + 3] * inv * bfhi(z.y)); }
                    const auto s0 = __builtin_amdgcn_permlane32_swap(w[0].x, w[1].x, false, false);
                    const auto s1 = __builtin_amdgcn_permlane32_swap(w[0].y, w[1].y, false, false);
                    u32x4 o; o.x = s0[0]; o.y = s1[0]; o.z = s0[1]; o.w = s1[1];
                    if (do_store) *(u32x4*)(op + 32 * blk + 16 * gp) = o;
                }
        }
        __syncthreads();
    }
}

DI void conv_fixup(const Params& P) {
    const int gtid = blockIdx.x * 512 + threadIdx.x, NT = gridDim.x * 512;
    unsigned char* ws = P.ws; bf16_t* A2 = (bf16_t*)(ws + WS_A2); const float* EDGE = (const float*)(ws + WS_EDGE); const float* cw = P.in[9];
    for (int i = gtid; i < 62 * 2 * 128; i += NT) {
        const int c8 = (i & 127) * 8, which = (i >> 7) & 1, bi = i >> 8;
        const int pm = bi < 31 ? bi + 1 : bi + 2;
        const size_t row = which == 0 ? (size_t)256 * pm : (size_t)256 * pm - 1;
        const float* gzp = EDGE + (size_t)((which == 0 ? pm : pm - 1) * 4 + (which == 0 ? 2 : 3)) * 1024 + c8;
        const float* cxp = EDGE + (size_t)((which == 0 ? pm - 1 : pm) * 4 + (which == 0 ? 1 : 0)) * 1024 + c8;
        const float* wp = cw + (which == 0 ? 0 : 2048) + c8;
        u32x4 v = *(const u32x4*)(A2 + row * 2048 + c8); unsigned va[4] = {v.x, v.y, v.z, v.w};
#pragma unroll
        for (int e = 0; e < 4; ++e) va[e] = pk2(bflo(va[e]) + gzp[2 * e] * wp[2 * e] * cxp[2 * e], bfhi(va[e]) + gzp[2 * e + 1] * wp[2 * e + 1] * cxp[2 * e + 1]);
        v.x = va[0]; v.y = va[1]; v.z = va[2]; v.w = va[3];
        *(u32x4*)(A2 + row * 2048 + c8) = v;
    }
}
DI void outw_phase(const Params& P, LAS unsigned char* lds) {
    const int tid = threadIdx.x, lane = tid & 63, wave = __builtin_amdgcn_readfirstlane(tid >> 6), gw = blockIdx.x * 8 + wave, NGW = gridDim.x * 8;
    unsigned char* ws = P.ws; LAS float* scr = (LAS float*)(lds + wave * 16384);
    bf16_t* W2T = (bf16_t*)(ws + WS_W2T); bf16_t* WOT = (bf16_t*)(ws + WS_WOT);
    for (int it = gw; it < 32 * 32 + 32 * 16; it += NGW) {
        if (it < 1024) { const int G = it >> 5, kb = it & 31; const float* W = kb < 16 ? P.in[12] : P.in[13];
            transpose_item(W, 1024, 64 * (kb & 15), 32 * G + perm32(4 * (lane & 7)), W2T, 2048, 64 * kb, 32 * G, scr, lane); }
        else { const int i2 = it - 1024, G = i2 >> 4, kb = i2 & 15;
            transpose_item(P.in[14], 1024, 64 * kb, 32 * G + perm32(4 * (lane & 7)), WOT, 1024, 64 * kb, 32 * G, scr, lane); }
    }
}

DI void final_phase(const Params& P) {
    const int tid = threadIdx.x, lane = tid & 63, wave = tid >> 6, gw = blockIdx.x * 8 + wave, NGW = gridDim.x * 8;
    unsigned char* ws = P.ws; const float* MOD = (const float*)(ws + WS_MOD); const float* Y = (const float*)(ws + WS_Y); const float* ssq = (const float*)(ws + WS_SSQ);
    const f32x4* pg = (const f32x4*)P.in[7] + lane;
    for (int m = gw; m < MTOK; m += NGW) {
        const int v = m >> 13; const float rstd = 1.0f / sqrtf(ssq[m] * (1.0f / DM) + 1e-6f);
        const f32x4* xr = (const f32x4*)(P.in[0] + (size_t)m * DM) + lane; const f32x4* yr = (const f32x4*)(Y + (size_t)m * DM) + lane;
        const f32x4* gt = (const f32x4*)(MOD + v * 3072 + 2048) + lane; f32x4* o = (f32x4*)(P.out + (size_t)m * DM) + lane;
#pragma unroll
        for (int j = 0; j < 4; ++j) { const f32x4 x = xr[64 * j], y = yr[64 * j], g = gt[64 * j], p = pg[64 * j]; o[64 * j] = x + g * ((y * rstd) * p); }
    }
}

typedef unsigned v4u __attribute__((ext_vector_type(4)));
#define XB_TMO      128
#define XB_XCNT(j)  (256  + 64 * (j))
#define XB_XSUB(j)  (1280 + 64 * (j))
#define XB_XGEN(j)  (2304 + 64 * (j))
#define XB_TOP      3328
#define XB_TOPGEN   3392
#define XCD_BAR_WORDS 3456
#define XB_SPIN_CAP (1u << 18)

__device__ __forceinline__ unsigned xb_ld(unsigned* p)              { return __hip_atomic_load(p, __ATOMIC_RELAXED, __HIP_MEMORY_SCOPE_AGENT); }
__device__ __forceinline__ unsigned xb_add(unsigned* p, unsigned v) { return __hip_atomic_fetch_add(p, v, __ATOMIC_RELAXED, __HIP_MEMORY_SCOPE_AGENT); }
__device__ __forceinline__ unsigned xb_xcc_id() { return (unsigned)__builtin_amdgcn_s_getreg((3 << 11) | 20) & 0xFu; }
#define XB_SPIN(cond, bar) do { unsigned _sp = 0; while (cond) { __builtin_amdgcn_s_sleep(1); \
    if ((++_sp & 255u) == 0u) { if (xb_ld(&(bar)[XB_TMO])) break; if (_sp > XB_SPIN_CAP) { atomicAdd(&(bar)[XB_TMO], 1u); break; } } } } while (0)

struct XcdBarrier {
    unsigned* bar; unsigned x;
    volatile LAS unsigned* st;
};

__device__ __forceinline__ XcdBarrier xcd_barrier_post(unsigned* bar, volatile LAS unsigned* st) {
    XcdBarrier b; b.bar = bar; b.x = xb_xcc_id(); b.st = st;
    if (threadIdx.x == 0) (void)xb_add(&bar[XB_XCNT(b.x)], 1u);
    return b;
}
__device__ __forceinline__ void xcd_barrier_complete(unsigned* bar, unsigned x, unsigned& nloc, unsigned& nx) {
    const unsigned G = gridDim.x * gridDim.y * gridDim.z;
    unsigned sum, cnt, mine, sp = 0u;
    for (;;) {
        sum = 0u; cnt = 0u; mine = 0u;
#pragma unroll
        for (unsigned j = 0; j < 16; ++j) { const unsigned c = xb_ld(&bar[XB_XCNT(j)]); sum += c; cnt += (c > 0u) ? 1u : 0u; mine = (j == x) ? c : mine; }
        if (sum == G) break;
        __builtin_amdgcn_s_sleep(1);
        if ((++sp & 255u) == 0u) { if (xb_ld(&bar[XB_TMO])) break; if (sp > XB_SPIN_CAP) { atomicAdd(&bar[XB_TMO], 1u); break; } }
    }
    nloc = mine > 0u ? mine : 1u; nx = cnt > 0u ? cnt : 1u;
}

__device__ __forceinline__ void xcd_barrier(const XcdBarrier& b) {
    asm volatile("s_waitcnt vmcnt(0)" ::: "memory");
    __syncthreads();
    if (threadIdx.x == 0) {
        unsigned* bar = b.bar;
        __builtin_amdgcn_s_waitcnt(0);
        unsigned nloc = b.st[0], nx = b.st[1];
        if (nloc == 0u) { xcd_barrier_complete(bar, b.x, nloc, nx); b.st[0] = nloc; b.st[1] = nx; }
        const unsigned old = xb_add(&bar[XB_XSUB(b.x)], 1u);
        const unsigned gen = old / nloc;
        if (old + 1u == (gen + 1u) * nloc) {
            __builtin_amdgcn_fence(__ATOMIC_RELEASE, "agent");
            asm volatile("s_waitcnt vmcnt(0)" ::: "memory");
            const unsigned og = xb_add(&bar[XB_TOP], 1u);
            const unsigned tg = og / nx;
            if (og + 1u == (tg + 1u) * nx) xb_add(&bar[XB_TOPGEN], 1u);
            else XB_SPIN(xb_ld(&bar[XB_TOPGEN]) == tg, bar);
            __builtin_amdgcn_fence(__ATOMIC_ACQUIRE, "agent");
            xb_add(&bar[XB_XGEN(b.x)], 1u);
            asm volatile("s_waitcnt vmcnt(0)" ::: "memory");
        } else {
            XB_SPIN(xb_ld(&bar[XB_XGEN(b.x)]) == gen, bar);
            __builtin_amdgcn_fence(__ATOMIC_ACQUIRE, "agent");
            asm volatile("s_waitcnt vmcnt(0)" ::: "memory");
        }
    }
    __syncthreads();
}

static __device__ unsigned g_bar[XCD_BAR_WORDS + 128];
#ifndef ONLY
#define PH(k) 1
#else
#define PH(k) ((k) == ONLY)
#endif
__global__ void __launch_bounds__(512) fwd_megakernel(Params P) {
    extern __shared__ __attribute__((aligned(16))) unsigned char lds_raw[];
    LAS unsigned char* lds = (LAS unsigned char*)lds_raw;
    cg::grid_group grid = cg::this_grid();
    unsigned char* ws = P.ws;
    const int G = gridDim.x, bx = blockIdx.x;
    volatile LAS unsigned* bst = (volatile LAS unsigned*)(lds + 131072 + 512);
    if (threadIdx.x < 2) bst[threadIdx.x] = 0u;
    __syncthreads();
    const XcdBarrier bar = xcd_barrier_post(g_bar, bst);
    if (P.flags == 0x7fffffff) grid.sync();
#define GRID_BAR() xcd_barrier(bar)

#if PH(0)
    phase0(P, lds);
    outw_phase(P, lds);
#endif
    GRID_BAR();
#if PH(1)
    ctx_kv(P, lds);
    phase1(P);
#endif
    GRID_BAR();
#if (PROBE_FLAGS + 0) & 1
    if (P.flags & 1) { phase0(P, lds); GRID_BAR(); phase1(P); GRID_BAR(); }
#endif
#if (PROBE_FLAGS + 0) & 16
    if (P.flags & 16) { GRID_BAR(); GRID_BAR(); GRID_BAR(); GRID_BAR(); }
#endif
#if PH(2)
    {
        pg8::Gemm g{(const bf16_t*)(ws + WS_H), (const bf16_t*)(ws + WS_WTIN), MTOK, 9216, DM};
        pg8::StaticOrder S; S.init(MTOK, 9216, G, bx);
        Epi1 E{(bf16_t*)(ws + WS_A2), (bf16_t*)(ws + WS_KB), (bf16_t*)(ws + WS_SZB), (bf16_t*)P.out, (bf16_t*)P.out + (size_t)MTOK * DM,
               (const float*)(ws + WS_ROPER), (const float*)(ws + WS_ROPEC), P.in[9], P.in[10], (float*)(ws + WS_EDGE), (LAS float*)(lds + 131072 + 1024)};
        pg8::gemm_phase<Epi1, pg8::StaticOrder, true, true, false, false>(lds, g, S, E);
#if (PROBE_FLAGS + 0) & 2
        if (P.flags & 2) { __syncthreads(); pg8::gemm_phase<Epi1, pg8::StaticOrder, true, true, false, false>(lds, g, S, E); }
#endif
    }
#endif
    __syncthreads();
#if PH(3)
    {
        pg8::Gemm g{(const bf16_t*)(ws + WS_H), (const bf16_t*)(ws + WS_WTIN) + (size_t)9216 * DM, MTOK, 1024, DM};
        pg8::StaticOrder S; S.init(MTOK, 1024, G, bx);
        EpiV E{(bf16_t*)(ws + WS_VT)};
        pg8::gemm_phase<EpiV, pg8::StaticOrder, true, true, true, false, true>(lds, g, S, E);
#if (PROBE_FLAGS + 0) & 32
        if (P.flags & 32) { __syncthreads(); pg8::gemm_phase<EpiV, pg8::StaticOrder, true, true, true, false, true>(lds, g, S, E); }
#endif
    }
#endif
    __syncthreads();
    GRID_BAR();
#if PH(5)
#if (PROBE_FLAGS + 0) & 4
    if (P.flags & 4) attn_phase(P, lds, (P.flags & 256) != 0);
#endif
    attn_phase(P, lds, true);
#endif
    conv_fixup(P);
    GRID_BAR();
#if PH(8)
    {
        pg8::Gemm g{(const bf16_t*)(ws + WS_A2), (const bf16_t*)(ws + WS_W2T), MTOK, 1024, 2048};
        pg8::StaticOrder S; S.init(MTOK, 1024, G, bx);
        Epi2 E{(const bf16_t*)P.out, (const bf16_t*)P.out + (size_t)MTOK * DM, (bf16_t*)(ws + WS_MRG)};
#if (PROBE_FLAGS + 0) & 8
        if (P.flags & 8) { Epi2 E2{(const bf16_t*)P.out, (const bf16_t*)P.out + (size_t)MTOK * DM, (bf16_t*)(ws + WS_MRG)}; pg8::gemm_phase<Epi2, pg8::StaticOrder, false, true, false, true>(lds, g, S, E2); __syncthreads(); }
#endif
        pg8::gemm_phase<Epi2, pg8::StaticOrder, true, true, false, true>(lds, g, S, E);
    }
#endif
    GRID_BAR();
#if PH(9)
    {
        pg8::Gemm g{(const bf16_t*)(ws + WS_MRG), (const bf16_t*)(ws + WS_WOT), MTOK, 1024, DM};
        pg8::StaticOrder S; S.init(MTOK, 1024, G, bx);
        EpiOut E{P.in[0], P.out, (const float*)(ws + WS_MOD), P.in[7], (float*)(ws + WS_XBUF), (unsigned*)(ws + WS_CNT)};
        pg8::gemm_phase<EpiOut, pg8::StaticOrder, false, true, false, false>(lds, g, S, E);
    }
#endif
    __syncthreads();
    if (threadIdx.x == 0) {
        const unsigned old = __hip_atomic_fetch_add(&g_bar[XCD_BAR_WORDS + 64], 1u, __ATOMIC_RELAXED, __HIP_MEMORY_SCOPE_AGENT);
        if (old == (unsigned)G - 1u) {
            __hip_atomic_store(&g_bar[XB_TMO], 0u, __ATOMIC_RELAXED, __HIP_MEMORY_SCOPE_AGENT);
            for (int j = 0; j < 16; ++j) { __hip_atomic_store(&g_bar[XB_XCNT(j)], 0u, __ATOMIC_RELAXED, __HIP_MEMORY_SCOPE_AGENT); __hip_atomic_store(&g_bar[XB_XSUB(j)], 0u, __ATOMIC_RELAXED, __HIP_MEMORY_SCOPE_AGENT);
                __hip_atomic_store(&g_bar[XB_XGEN(j)], 0u, __ATOMIC_RELAXED, __HIP_MEMORY_SCOPE_AGENT); }
            __hip_atomic_store(&g_bar[XB_TOP], 0u, __ATOMIC_RELAXED, __HIP_MEMORY_SCOPE_AGENT); __hip_atomic_store(&g_bar[XB_TOPGEN], 0u, __ATOMIC_RELAXED, __HIP_MEMORY_SCOPE_AGENT);
            __hip_atomic_store(&g_bar[XCD_BAR_WORDS + 64], 0u, __ATOMIC_RELAXED, __HIP_MEMORY_SCOPE_AGENT);
        }
    }
}

extern "C" void kernel_launch(void* const* d_in, const int* in_sizes, int n_in, void* d_out, int out_size, void* d_ws, size_t ws_size, hipStream_t stream) {
    static int grid = 0;
    if (grid == 0) {
        if (n_in != 15 || in_sizes[0] != MTOK * DM || out_size != MTOK * DM || ws_size < WS_END) {
            fprintf(stderr, "kernel_launch: unexpected shapes (n_in %d, in0 %d, out %d, ws %zu)\n", n_in, n_in > 0 ? in_sizes[0] : -1, out_size, ws_size); grid = -1; return; }
        int dev = 0, cus = 0, per_cu = 0;
        (void)hipGetDevice(&dev); (void)hipDeviceGetAttribute(&cus, hipDeviceAttributeMultiprocessorCount, dev);
        if (hipFuncSetAttribute((const void*)fwd_megakernel, hipFuncAttributeMaxDynamicSharedMemorySize, LDS_BYTES) != hipSuccess) { fprintf(stderr, "kernel_launch: hipFuncSetAttribute failed\n"); grid = -1; return; }
        if (hipOccupancyMaxActiveBlocksPerMultiprocessor(&per_cu, (const void*)fwd_megakernel, 512, LDS_BYTES) != hipSuccess || per_cu < 1) { fprintf(stderr, "kernel_launch: occupancy query says %d\n", per_cu); per_cu = 1; }
        (void)hipGetLastError();
        grid = cus > 0 ? cus : 256;
        if (grid % 8 != 0) grid -= grid % 8;
    }
    if (grid < 0) return;
    Params p{};
    for (int i = 0; i < 15; ++i) p.in[i] = (const float*)d_in[i];
    p.out = (float*)d_out; p.ws = (unsigned char*)d_ws;
    p.flags = PROBE_FLAGS;
    void* args[] = {&p};
    hipError_t e = hipLaunchCooperativeKernel((const void*)fwd_megakernel, dim3(grid), dim3(512), args, LDS_BYTES, stream);
    if (e != hipSuccess) fprintf(stderr, "kernel_launch: cooperative launch failed: %s (grid %d)\n", hipGetErrorString(e), grid);
}
```

```cpp
#ifndef PROBE_FLAGS
#define PROBE_FLAGS 0
#endif
#include <hip/hip_runtime.h>
#include <hip/hip_cooperative_groups.h>
#include <cstdio>
#include <cstdint>
namespace cg = cooperative_groups;
#define DI __device__ __forceinline__
typedef float f32x2_t __attribute__((ext_vector_type(2)));
typedef __bf16 bf16x2_t __attribute__((ext_vector_type(2)));
typedef float f32x16 __attribute__((ext_vector_type(16)));
typedef unsigned u32x2 __attribute__((ext_vector_type(2)));
DI unsigned pk2(float lo, float hi) { f32x2_t v = {lo, hi}; bf16x2_t b = __builtin_convertvector(v, bf16x2_t); return __builtin_bit_cast(unsigned, b); }
DI float bflo(unsigned u) { return __uint_as_float(u << 16); }
DI float bfhi(unsigned u) { return __uint_as_float(u & 0xffff0000u); }
DI float fsigm(float z) { return __builtin_amdgcn_rcpf(1.0f + __builtin_amdgcn_exp2f(z * -1.4426950408889634f)); }
DI float fsilu(float z) { return z * fsigm(z); }
namespace pg8 {
#define PG8_LAS __attribute__((address_space(3)))
typedef unsigned short bf16_t;
typedef short bf16x8 __attribute__((ext_vector_type(8)));
typedef float f32x4 __attribute__((ext_vector_type(4)));
typedef unsigned u32x4 __attribute__((ext_vector_type(4)));
constexpr int BM = 256, BK = 64, HALF = 128, HTB = HALF * BK * 2  , STAGE_BYTES = 8 * HTB, NXCD = 8, WGM = 8;

__host__ __device__ __forceinline__ int lds_byte(int r, int c) { const int st = (r >> 4) * 2 + (c >> 5), rr = r & 15, cc = c & 31, ob = rr * 64 + cc * 2; return st * 1024 + (ob ^ (((ob >> 9) & 1) << 5)); }
__host__ __device__ __forceinline__ void stage_rc(int b, int& R, int& C) { const int st = b / 1024, sb = b % 1024, swz = sb ^ (((sb >> 9) & 1) << 5); R = (st >> 1) * 16 + swz / 64; C = (st & 1) * 32 + (swz % 64) / 2; }
__host__ __device__ __forceinline__ int perm32(int rho) { const int n = rho >> 4, i = rho & 15; return 8 * (i >> 2) + 4 * n + (i & 3); }

struct Unit { int pm, pn; };
struct Gemm { const bf16_t* A; const bf16_t* Bt; int M, N, K; };

struct StaticOrder {
    int nM, nN, nwg, G, c;
    __host__ __device__ void init(int M, int N, int G_, int c_) { nM = M / BM; nN = N / BM; nwg = nM * nN; G = G_; c = c_; }
    __host__ __device__ bool next(int i, Unit& u) const {
        const long L = (long)i * G + c; if (L >= nwg) return false;
        int wgid = (int)L; { const int q = nwg / NXCD, r = nwg % NXCD, xcd = wgid % NXCD, off = wgid / NXCD; wgid = (xcd < r ? xcd * (q + 1) : r * (q + 1) + (xcd - r) * q) + off; }
        const int nig = WGM * nN, gid = wgid / nig, fm = gid * WGM, gsz = (nM - fm) < WGM ? (nM - fm) : WGM;
        u.pm = fm + ((wgid % nig) % gsz); u.pn = (wgid % nig) / gsz; return true;
    }
    __device__ __forceinline__ void a_ready(const Unit&) const {}
    __device__ __forceinline__ void done(const Unit&) const {}
};

template <class Epi, class Sched, bool ALIGN_EPI = false, bool SP2 = false, bool SWAP = false, bool HOOK = false, bool PERMA = false  >
__device__ __forceinline__ void gemm_phase(PG8_LAS unsigned char* lds, const Gemm g, const Sched& S, const Epi& E) {
    int tid_ = threadIdx.x; asm volatile("" : "+v"(tid_));
    const int tid = tid_, wid = __builtin_amdgcn_readfirstlane(tid >> 6), lane = tid & 63, wr = wid >> 2, wc = wid & 3, fr = lane & 15, fq = lane >> 4;
    const int K = g.K, nt = K / BK;
    unsigned voffA[2], voffB[2];
#pragma unroll
    for (int i = 0; i < 2; ++i) { int R, C; stage_rc(tid * 16 + i * 8192, R, C); const int Rb = R; const int Ra = PERMA ? ((R & ~31) + perm32(R & 31)) : R;
        voffA[i] = (unsigned)(Ra * K + C) * 2u; voffB[i] = (unsigned)(Rb * K + C) * 2u; }
    const size_t kstep = (size_t)(BK * 2);
    const size_t hstep = (size_t)HALF * K * 2;
    const size_t tstep = 2 * hstep;
    const unsigned ldsw = (unsigned)wid * 1024u;
    const int aoff = lds_byte(wr * 64 + fr, fq * 8), boff = lds_byte(wc * 32 + fr, fq * 8);
#define PG8_SA(b, h) (((b) * 2 + (h)) * HTB)
#define PG8_SB(b, h) ((4 + (b) * 2 + (h)) * HTB)
#define PG8_STAGE(bufoff, gbase, voff) do { _Pragma("unroll") for (int _i = 0; _i < 2; ++_i) \
        __builtin_amdgcn_global_load_lds((const unsigned*)((const char*)(gbase) + (voff)[_i]), (PG8_LAS unsigned*)(lds + (bufoff) + ldsw + _i * 8192), 16, 0, 0); } while (0)
#define PG8_LDA(dst, b, h) do { _Pragma("unroll") for (int m = 0; m < 4; ++m) _Pragma("unroll") for (int k = 0; k < 2; ++k) dst[m][k] = *(const PG8_LAS bf16x8*)(lds + PG8_SA(b, h) + aoff + m * 2048 + k * 1024); } while (0)
#define PG8_LDB(dst, b, h) do { _Pragma("unroll") for (int n = 0; n < 2; ++n) _Pragma("unroll") for (int k = 0; k < 2; ++k) dst[n][k] = *(const PG8_LAS bf16x8*)(lds + PG8_SB(b, h) + boff + n * 2048 + k * 1024); } while (0)
#define PG8_MMA(ai, bj, At, Bt) do { __builtin_amdgcn_s_setprio(1); _Pragma("unroll") for (int m = 0; m < 4; ++m) _Pragma("unroll") for (int n = 0; n < 2; ++n) _Pragma("unroll") for (int k = 0; k < 2; ++k) \
        acc[ai][bj][m][n] = SWAP ? __builtin_amdgcn_mfma_f32_16x16x32_bf16(At[m][k], Bt[n][k], acc[ai][bj][m][n], 0, 0, 0) : __builtin_amdgcn_mfma_f32_16x16x32_bf16(Bt[n][k], At[m][k], acc[ai][bj][m][n], 0, 0, 0); __builtin_amdgcn_s_setprio(0); } while (0)
#define PG8_WAIT_V(n) asm volatile("s_waitcnt vmcnt(" #n ")" ::: "memory")
#define PG8_WAIT_L(n) asm volatile("s_waitcnt lgkmcnt(" #n ")" ::: "memory")
#define PG8_BAR __builtin_amdgcn_s_barrier()
#define PG8_SCHED __builtin_amdgcn_sched_barrier(0)
    Unit cur, nxt; int ui = 0;
    if (!S.next(0, cur)) return;
    f32x4 acc[2][2][4][2];
#pragma unroll
    for (int a = 0; a < 2; ++a)
#pragma unroll
        for (int b = 0; b < 2; ++b)
#pragma unroll
            for (int m = 0; m < 4; ++m)
#pragma unroll
                for (int n = 0; n < 2; ++n) acc[a][b][m][n] = (f32x4){0.f, 0.f, 0.f, 0.f};
    bf16x8 At[4][2], B0[2][2], B1[2][2];
    const char* cA = (const char*)g.A + (size_t)cur.pm * tstep; const char* cB = (const char*)g.Bt + (size_t)cur.pn * tstep;
    S.a_ready(cur);
    if constexpr (SP2) {
        PG8_STAGE(PG8_SB(0, 0), cB, voffB); PG8_STAGE(PG8_SB(0, 1), cB + hstep, voffB); PG8_STAGE(PG8_SA(0, 0), cA, voffA); PG8_STAGE(PG8_SA(0, 1), cA + hstep, voffA);
        if (wr == 1) PG8_BAR;
        PG8_WAIT_V(2); PG8_BAR;
        PG8_STAGE(PG8_SB(1, 0), cB + kstep, voffB); PG8_STAGE(PG8_SA(1, 0), cA + kstep, voffA); PG8_STAGE(PG8_SB(1, 1), cB + hstep + kstep, voffB);
        PG8_WAIT_V(6); PG8_BAR;
    } else {
        PG8_STAGE(PG8_SB(0, 0), cB, voffB); PG8_STAGE(PG8_SA(0, 0), cA, voffA); PG8_STAGE(PG8_SB(0, 1), cB + hstep, voffB); PG8_STAGE(PG8_SA(0, 1), cA + hstep, voffA);
        if (wr == 1) PG8_BAR;
        PG8_WAIT_V(4); PG8_BAR;
        PG8_STAGE(PG8_SB(1, 0), cB + kstep, voffB); PG8_STAGE(PG8_SA(1, 0), cA + kstep, voffA); PG8_STAGE(PG8_SB(1, 1), cB + hstep + kstep, voffB);
        PG8_WAIT_V(6); PG8_BAR;
    }
    for (;;) {
        const bool has_next = S.next(ui + 1, nxt);
        const char* nA = has_next ? (const char*)g.A + (size_t)nxt.pm * tstep : cA; const char* nB = has_next ? (const char*)g.Bt + (size_t)nxt.pn * tstep : cB;
        for (int t = 0; t < nt; t += 2) {
            const bool last = (t == nt - 2);
            if constexpr (HOOK) { if (t == (nt >> 1)) E.mid(acc, cur, wr, wc, fr, fq); }
            const char* a1 = cA + (size_t)(t + 1) * kstep;
            const char* a2 = last ? nA : cA + (size_t)(t + 2) * kstep; const char* b2 = last ? nB : cB + (size_t)(t + 2) * kstep;
            const char* a3 = a2 + kstep; const char* b3 = b2 + kstep;
            if (last && has_next) S.a_ready(nxt);
            if constexpr (SP2) {
            PG8_LDB(B0, 0, 0); PG8_LDB(B1, 0, 1); PG8_SCHED; PG8_LDA(At, 0, 0); PG8_STAGE(PG8_SA(1, 1), a1 + hstep, voffA);
            PG8_WAIT_V(8); PG8_WAIT_L(0); PG8_BAR; PG8_MMA(0, 0, At, B0); PG8_MMA(0, 1, At, B1); PG8_BAR; PG8_SCHED;
            PG8_LDA(At, 0, 1); PG8_STAGE(PG8_SB(0, 0), b2, voffB); PG8_STAGE(PG8_SB(0, 1), b2 + hstep, voffB); PG8_STAGE(PG8_SA(0, 0), a2, voffA);
            PG8_WAIT_V(8); PG8_WAIT_L(0); PG8_BAR; PG8_MMA(1, 0, At, B0); PG8_MMA(1, 1, At, B1); PG8_BAR; PG8_SCHED;
            PG8_LDB(B0, 1, 0); PG8_LDB(B1, 1, 1); PG8_SCHED; PG8_LDA(At, 1, 0); PG8_STAGE(PG8_SA(0, 1), a2 + hstep, voffA);
            PG8_WAIT_V(8); PG8_WAIT_L(0); PG8_BAR; PG8_MMA(0, 0, At, B0); PG8_MMA(0, 1, At, B1); PG8_BAR; PG8_SCHED;
            PG8_LDA(At, 1, 1); PG8_STAGE(PG8_SB(1, 0), b3, voffB); PG8_STAGE(PG8_SB(1, 1), b3 + hstep, voffB); PG8_STAGE(PG8_SA(1, 0), a3, voffA);
            PG8_WAIT_V(8); PG8_WAIT_L(0); PG8_BAR; PG8_MMA(1, 0, At, B0); PG8_MMA(1, 1, At, B1); PG8_BAR; PG8_SCHED;
            } else {
            PG8_LDB(B0, 0, 0); PG8_SCHED; PG8_LDA(At, 0, 0); PG8_STAGE(PG8_SA(1, 1), a1 + hstep, voffA);
            PG8_WAIT_L(8); PG8_BAR; PG8_WAIT_L(0); PG8_MMA(0, 0, At, B0); PG8_BAR; PG8_SCHED;
            PG8_LDB(B1, 0, 1); PG8_STAGE(PG8_SB(0, 0), b2, voffB);
            PG8_BAR; PG8_WAIT_L(0); PG8_MMA(0, 1, At, B1); PG8_BAR;
            PG8_LDA(At, 0, 1); PG8_STAGE(PG8_SA(0, 0), a2, voffA);
            PG8_BAR; PG8_WAIT_L(0); PG8_MMA(1, 0, At, B0); PG8_BAR; PG8_SCHED;
            PG8_STAGE(PG8_SB(0, 1), b2 + hstep, voffB);
            PG8_WAIT_V(6); PG8_BAR; PG8_MMA(1, 1, At, B1); PG8_BAR;
            PG8_LDB(B0, 1, 0); PG8_SCHED; PG8_LDA(At, 1, 0); PG8_STAGE(PG8_SA(0, 1), a2 + hstep, voffA);
            PG8_WAIT_L(8); PG8_BAR; PG8_WAIT_L(0); PG8_MMA(0, 0, At, B0); PG8_BAR; PG8_SCHED;
            PG8_LDB(B1, 1, 1); PG8_STAGE(PG8_SB(1, 0), b3, voffB);
            PG8_BAR; PG8_WAIT_L(0); PG8_MMA(0, 1, At, B1); PG8_BAR;
            PG8_LDA(At, 1, 1); PG8_STAGE(PG8_SA(1, 0), a3, voffA);
            PG8_BAR; PG8_WAIT_L(0); PG8_MMA(1, 0, At, B0); PG8_BAR; PG8_SCHED;
            PG8_STAGE(PG8_SB(1, 1), b3 + hstep, voffB);
            PG8_WAIT_V(6); PG8_BAR; PG8_MMA(1, 1, At, B1); PG8_BAR;
            }
        }
        if constexpr (ALIGN_EPI) { if (wr == 0) PG8_BAR; }
        if constexpr (!Epi::AFTER_DRAIN) { E(acc, cur, wr, wc, fr, fq); S.done(cur); }
        if (!has_next) break;
#pragma unroll
        for (int a = 0; a < 2; ++a)
#pragma unroll
            for (int b = 0; b < 2; ++b)
#pragma unroll
                for (int m = 0; m < 4; ++m)
#pragma unroll
                    for (int n = 0; n < 2; ++n) acc[a][b][m][n] = (f32x4){0.f, 0.f, 0.f, 0.f};
        cur = nxt; cA = nA; cB = nB; ++ui;
        if constexpr (ALIGN_EPI) { if (wr == 1) PG8_BAR; }
    }
    PG8_WAIT_V(0);
    if constexpr (!ALIGN_EPI) { if (wr == 0) PG8_BAR; }
    PG8_BAR;
    if constexpr (Epi::AFTER_DRAIN) { E.fused(acc, cur, wr, wc, fr, fq, lds, wid, lane); S.done(cur); }
#undef PG8_SA
#undef PG8_SB
#undef PG8_STAGE
#undef PG8_LDA
#undef PG8_LDB
#undef PG8_MMA
#undef PG8_WAIT_V
#undef PG8_WAIT_L
#undef PG8_BAR
#undef PG8_SCHED
}
}

typedef unsigned short bf16_t;
typedef short bf16x8 __attribute__((ext_vector_type(8)));
typedef float f32x4 __attribute__((ext_vector_type(4)));
typedef unsigned u32x4 __attribute__((ext_vector_type(4)));
#define LAS __attribute__((address_space(3)))
constexpr int DM = 1024, SEQ = 8192, NB = 2, MTOK = NB * SEQ, CTX = 256, NH = 16, HD = 64, INC = 10240;
constexpr size_t MiB = 1u << 20;
constexpr size_t WS_MOD = 0, WS_SSQ = 65536, WS_ROPER = 131072, WS_ROPEC = 147456, WS_BAR = 196608, WS_CNT = 196608 + 16384, WS_BAR_BYTES = 32768, WS_XBUF = 524288, WS_BT = 1 * MiB, WS_WTIN = 6 * MiB, WS_HC = 26 * MiB, WS_KC = 27 * MiB, WS_VTC = 28 * MiB,
                 WS_EDGE = 29 * MiB, WS_H = 32 * MiB, WS_A2 = 64 * MiB, WS_W2T = 128 * MiB, WS_WOT = 132 * MiB, WS_KB = 160 * MiB, WS_MRG = 160 * MiB, WS_Y = 160 * MiB,
                 WS_VT = 192 * MiB, WS_SZB = 224 * MiB, WS_END = 256 * MiB;
constexpr int LDS_BYTES = 147456;
constexpr float LOG2E = 1.4426950408889634f;
constexpr float QSCALE = 0.125f * LOG2E;
constexpr int BT_VARS = 15, BT_BLKS = 9;

struct Params { const float* in[15]; float* out; unsigned char* ws; int flags; int pad; };

DI int perm32(int rho) { const int n = rho >> 4, i = rho & 15; return 8 * (i >> 2) + 4 * n + (i & 3); }
DI int swap23(int i) { return (i & 0x13) | ((i & 4) << 1) | ((i & 8) >> 1); }
DI int crow(int r, int hi) { return (r & 3) + 8 * (r >> 2) + 4 * hi; }
DI int iclip(int v, int lo, int hi) { return v < lo ? lo : (v > hi ? hi : v); }
DI float wave_sum(float v) {
#pragma unroll
    for (int o = 1; o < 64; o <<= 1) v += __shfl_xor(v, o);
    return v;
}
DI int wtin_src_col(int R) {
    if (R < 4096) { const int jt = R >> 8, q = R & 255, bj = q >> 7, wc = (q >> 5) & 3, n = (q >> 4) & 1, i = q & 15; return (2 * bj + n) * 1024 + 64 * jt + 16 * wc + i; }
    if (R < 6144) return R;
    if (R < 9216) return (R & ~31) + 1024 + perm32(R & 31);
    return R - 3072;
}

template <int CTRL> DI float dpp_keep(float oldv, float x) {
    return __builtin_bit_cast(float, __builtin_amdgcn_update_dpp(__builtin_bit_cast(int, oldv), __builtin_bit_cast(int, x), CTRL, 0xf, 0xf, false));
}
struct Epi1 {
    static constexpr bool AFTER_DRAIN = false;
    bf16_t *A2, *KB, *SZB, *SGA, *SGB; const float *roper, *ropec; const float *CW, *CBIAS; float* EDGE; LAS float* EX;
    DI void operator()(const f32x4 (&acc)[2][2][4][2], const pg8::Unit& u, int wr, int wc, int fr, int fq) const {
        const int row0 = u.pm * 256 + wr * 64 + fr;
        if (u.pn < 16) {
            const int ch = 64 * u.pn + 16 * wc + 4 * fq, cl = 16 * wc + 4 * fq;
            f32x4 cx[2][4];
#pragma unroll
            for (int ai = 0; ai < 2; ++ai)
#pragma unroll
                for (int m = 0; m < 4; ++m) cx[ai][m] = acc[ai][0][m][1] * acc[ai][1][m][0];
#pragma unroll
            for (int ai = 0; ai < 2; ++ai) { const int s = 2 * ai + wr;
                if (fr == 0) *(LAS f32x4*)(EX + s * 64 + cl) = cx[ai][0];
                if (fr == 15) *(LAS f32x4*)(EX + 256 + s * 64 + cl) = cx[ai][3]; }
            asm volatile("s_waitcnt lgkmcnt(0)" ::: "memory"); __builtin_amdgcn_s_barrier(); asm volatile("" ::: "memory");
            const f32x4 w0 = *(const f32x4*)(CW + ch), w1 = *(const f32x4*)(CW + 1024 + ch), w2 = *(const f32x4*)(CW + 2048 + ch), cb = *(const f32x4*)(CBIAS + ch);
            const f32x4 zero4 = {0.f, 0.f, 0.f, 0.f};
#pragma unroll
            for (int ai = 0; ai < 2; ++ai) { const int s = 2 * ai + wr;
                const f32x4 hup = s > 0 ? *(const LAS f32x4*)(EX + 256 + (s - 1) * 64 + cl) : zero4;
                const f32x4 hdn = s < 3 ? *(const LAS f32x4*)(EX + (s + 1) * 64 + cl) : zero4;
                u32x2 wq[4];
#pragma unroll
                for (int m = 0; m < 4; ++m) {
                    const f32x4 bg = acc[ai][0][m][0], za = acc[ai][1][m][1]; f32x4 gz, ua;
#pragma unroll
                    for (int j = 0; j < 4; ++j) {
                        gz[j] = fsilu(za[j]) * bg[j];
                        const float wu = m > 0 ? dpp_keep<0x10F>(0.f, cx[ai][m > 0 ? m - 1 : 0][j]) : hup[j];
                        const float up = dpp_keep<0x111>(wu, cx[ai][m][j]);
                        const float wd = m < 3 ? dpp_keep<0x11F>(0.f, cx[ai][m < 3 ? m + 1 : 3][j]) : hdn[j];
                        const float dn = dpp_keep<0x101>(wd, cx[ai][m][j]);
                        ua[j] = gz[j] * (w0[j] * up + w1[j] * cx[ai][m][j] + w2[j] * dn + cb[j]);
                    }
                    wq[m].x = pk2(ua[0], ua[1]); wq[m].y = pk2(ua[2], ua[3]);
                    if (ai == 0 && m == 0 && wr == 0 && fr == 0) { *(f32x4*)(EDGE + (size_t)(u.pm * 4 + 0) * 1024 + ch) = cx[0][0]; *(f32x4*)(EDGE + (size_t)(u.pm * 4 + 2) * 1024 + ch) = gz; }
                    if (ai == 1 && m == 3 && wr == 1 && fr == 15) { *(f32x4*)(EDGE + (size_t)(u.pm * 4 + 1) * 1024 + ch) = cx[1][3]; *(f32x4*)(EDGE + (size_t)(u.pm * 4 + 3) * 1024 + ch) = gz; }
                }
#pragma unroll
                for (int p = 0; p < 2; ++p) {
                    const auto s0 = __builtin_amdgcn_permlane16_swap(wq[2 * p].x, wq[2 * p + 1].x, false, false);
                    const auto s1 = __builtin_amdgcn_permlane16_swap(wq[2 * p].y, wq[2 * p + 1].y, false, false);
                    u32x4 o; o.x = s0[0]; o.y = s1[0]; o.z = s0[1]; o.w = s1[1];
                    *(u32x4*)(A2 + (size_t)(row0 + 128 * ai + 16 * (2 * p + (fq & 1))) * 2048 + 64 * u.pn + 16 * wc + 8 * (fq >> 1)) = o;
                }
            }
        } else if (u.pn < 24) {
            const bool isq = u.pn < 20;
            const int ct = (u.pn - (isq ? 16 : 20)) * 256;
            bf16_t* dst = isq ? (A2 + 1024) : KB; const size_t pitch = isq ? 2048 : 1024; const float sc = isq ? QSCALE : 1.0f;
            const int chunk = 4 * (wc & 1) + fq;
            bf16_t* pr = isq ? dst + (size_t)row0 * pitch + ct + 32 * wc + 8 * fq
                             : KB + (size_t)(u.pm >> 5) * 8388608 + (size_t)((u.pn - 20) * 4 + (wc >> 1)) * 524288 + (size_t)(4 * (u.pm & 31) + wr) * 4096
                                  + (fr >> 3) * 512 + (chunk >> 1) * 128 + (chunk & 1) * 64 + (fr & 7) * 8;
            const size_t sM = isq ? (size_t)16 * 2048 : 1024, sA = isq ? (size_t)64 * 2048 : (8192 - 4 * 1024), sB = isq ? 128 : 1048576;
#pragma unroll
            for (int ai = 0; ai < 2; ++ai) {
#pragma unroll
                for (int m = 0; m < 4; ++m) {
                    const int t = (row0 + 128 * ai + 16 * m) & (SEQ - 1);
                    const float* tab = (wc & 1) ? (ropec + (t & 63) * 32) : (roper + (t >> 6) * 32);
                    const f32x4 cs = *(const f32x4*)(tab + 4 * fq), sn = *(const f32x4*)(tab + 16 + 4 * fq);
                    asm volatile("" : "+v"(pr));
#pragma unroll
                    for (int bj = 0; bj < 2; ++bj) {
                        const f32x4 u1 = acc[ai][bj][m][0], u2 = acc[ai][bj][m][1];
                        const f32x4 o1 = (u1 * cs - u2 * sn) * sc, o2 = (u2 * cs + u1 * sn) * sc;
                        u32x4 w; w.x = pk2(o1[0], o1[1]); w.y = pk2(o1[2], o1[3]); w.z = pk2(o2[0], o2[1]); w.w = pk2(o2[2], o2[3]);
                        *(u32x4*)(pr + (bj ? sB : 0)) = w;
                    }
                    pr += sM;
                }
                pr += sA;
            }
        } else {
            const int ty = (u.pn - 24) >> 2;
            const int ct = ((u.pn - 24) & 3) * 256;
            int frl = fr, fql = fq; asm volatile("" : "+v"(frl), "+v"(fql));
            bf16_t* dst = SGA + (size_t)(ty == 2 ? 1 : 0) * ((size_t)MTOK * DM); if (ty == 0) dst = SZB;
#pragma unroll
            for (int ai = 0; ai < 2; ++ai)
#pragma unroll
                for (int m = 0; m < 4; ++m) {
                    const size_t row = (size_t)(row0 + 128 * ai + 16 * m);
#pragma unroll
                    for (int bj = 0; bj < 2; ++bj) {
                        f32x4 v0 = acc[ai][bj][m][0], v1 = acc[ai][bj][m][1];
                        if (ty == 0) {
#pragma unroll
                            for (int j = 0; j < 4; ++j) { v0[j] = fsilu(v0[j]); v1[j] = fsilu(v1[j]); }
                        } else {
#pragma unroll
                            for (int j = 0; j < 4; ++j) { v0[j] = fsigm(v0[j]); v1[j] = fsigm(v1[j]); }
                        }
                        u32x4 w; w.x = pk2(v0[0], v0[1]); w.y = pk2(v0[2], v0[3]); w.z = pk2(v1[0], v1[1]); w.w = pk2(v1[2], v1[3]);
                        if (ty == 0) *(u32x4*)(dst + row * 1024 + ct + 128 * bj + 32 * wc + 8 * fql) = w;
                        else *(u32x4*)(dst + (size_t)(u.pm * 4 + (ct >> 8)) * 65536 + ai * 32768 + m * 8192 + bj * 4096 + (wr * 4 + wc) * 512 + (fql * 16 + frl) * 8) = w;
                    }
                }
        }
    }
};
struct EpiV {
    static constexpr bool AFTER_DRAIN = false;
    bf16_t* VT;
    DI void operator()(const f32x4 (&acc)[2][2][4][2], const pg8::Unit& u, int wr, int wc, int fr, int fq) const {
        const int tok0 = u.pm * 256 + wr * 64 + 8 * fq;
#pragma unroll
        for (int bj = 0; bj < 2; ++bj)
#pragma unroll
            for (int n = 0; n < 2; ++n) {
                const int col = u.pn * 256 + 128 * bj + 32 * wc + 16 * n + fr;
#pragma unroll
                for (int ai = 0; ai < 2; ++ai)
#pragma unroll
                    for (int p = 0; p < 2; ++p) {
                        const int tok = tok0 + 128 * ai + 32 * p; const int b = tok >> 13, t = tok & (SEQ - 1);
                        const f32x4 v0 = acc[ai][bj][2 * p][n], v1 = acc[ai][bj][2 * p + 1][n];
                        u32x4 w; w.x = pk2(v0[0], v0[1]); w.y = pk2(v0[2], v0[3]); w.z = pk2(v1[0], v1[1]); w.w = pk2(v1[2], v1[3]);
                        *(u32x4*)(VT + (size_t)(b * NH + (col >> 6)) * 524288 + (size_t)(t >> 6) * 4096 + ((t & 63) >> 3) * 512 + (col & 63) * 8) = w;
                    }
            }
    }
};
struct Epi2 {
    static constexpr bool AFTER_DRAIN = false;
    const bf16_t *SGA, *SGB; bf16_t* MRG;
    DI void mid(f32x4 (&acc)[2][2][4][2], const pg8::Unit& u, int wr, int wc, int fr, int fq) const {
        const size_t img = (size_t)(u.pm * 4 + u.pn) * 65536 + (wr * 4 + wc) * 512 + (fq * 16 + fr) * 8;
#pragma unroll
        for (int ai = 0; ai < 2; ++ai) {
            const bf16_t* pa = SGA + img + (size_t)ai * 32768; const bf16_t* pb = SGB + img + (size_t)ai * 32768;
            asm volatile("" : "+v"(pa), "+v"(pb) :: "memory");
            u32x4 a[4][2], b[4][2];
#pragma unroll
            for (int m = 0; m < 4; ++m)
#pragma unroll
                for (int bj = 0; bj < 2; ++bj) { a[m][bj] = __builtin_nontemporal_load((const u32x4*)(pa + m * 8192 + 4096 * bj)); b[m][bj] = *(const u32x4*)(pb + m * 8192 + 4096 * bj); }
#pragma unroll
            for (int m = 0; m < 4; ++m)
#pragma unroll
                for (int bj = 0; bj < 2; ++bj) {
                    const u32x4 A = a[m][bj], B = b[m][bj]; f32x4 r0, r1;
                    r0[0] = bflo(A.x) * __builtin_amdgcn_rcpf(bflo(B.x)); r0[1] = bfhi(A.x) * __builtin_amdgcn_rcpf(bfhi(B.x)); r0[2] = bflo(A.y) * __builtin_amdgcn_rcpf(bflo(B.y)); r0[3] = bfhi(A.y) * __builtin_amdgcn_rcpf(bfhi(B.y));
                    r1[0] = bflo(A.z) * __builtin_amdgcn_rcpf(bflo(B.z)); r1[1] = bfhi(A.z) * __builtin_amdgcn_rcpf(bfhi(B.z)); r1[2] = bflo(A.w) * __builtin_amdgcn_rcpf(bflo(B.w)); r1[3] = bfhi(A.w) * __builtin_amdgcn_rcpf(bfhi(B.w));
                    acc[ai][bj][m][0] *= r0; acc[ai][bj][m][1] *= r1;
                }
            asm volatile("" ::: "memory");
        }
    }
    DI void operator()(const f32x4 (&acc)[2][2][4][2], const pg8::Unit& u, int wr, int wc, int fr, int fq) const {
        const size_t base = (size_t)(u.pm * 256 + wr * 64 + fr) * 1024 + u.pn * 256 + 32 * wc + 8 * fq;
        const size_t img = (size_t)(u.pm * 4 + u.pn) * 65536 + (wr * 4 + wc) * 512 + (fq * 16 + fr) * 8;
#pragma unroll
        for (int ai = 0; ai < 2; ++ai) {
            const bf16_t* pb = SGB + img + (size_t)ai * 32768; bf16_t* po = MRG + base + (size_t)ai * (128 * 1024);
            asm volatile("" : "+v"(pb), "+v"(po) :: "memory");
            u32x4 b[4][2];
#pragma unroll
            for (int m = 0; m < 4; ++m)
#pragma unroll
                for (int bj = 0; bj < 2; ++bj) b[m][bj] = __builtin_nontemporal_load((const u32x4*)(pb + m * 8192 + 4096 * bj));
#pragma unroll
            for (int m = 0; m < 4; ++m)
#pragma unroll
                for (int bj = 0; bj < 2; ++bj) {
                    const u32x4 B = b[m][bj]; const f32x4 v0 = acc[ai][bj][m][0], v1 = acc[ai][bj][m][1];
                    u32x4 w; w.x = pk2(v0[0] * bflo(B.x), v0[1] * bfhi(B.x)); w.y = pk2(v0[2] * bflo(B.y), v0[3] * bfhi(B.y));
                    w.z = pk2(v1[0] * bflo(B.z), v1[1] * bfhi(B.z)); w.w = pk2(v1[2] * bflo(B.w), v1[3] * bfhi(B.w));
                    *(u32x4*)(po + m * (16 * 1024) + 128 * bj) = w;
                }
            asm volatile("" ::: "memory");
        }
    }
};
struct Epi3 {
    static constexpr bool AFTER_DRAIN = false;
    float* Y; float* SSQ;
    DI void operator()(const f32x4 (&acc)[2][2][4][2], const pg8::Unit& u, int wr, int wc, int fr, int fq) const {
        const int row0 = u.pm * 256 + wr * 64 + fr, col0 = u.pn * 256 + 32 * wc + 8 * fq;
#pragma unroll
        for (int ai = 0; ai < 2; ++ai)
#pragma unroll
            for (int m = 0; m < 4; ++m) {
                const int row = row0 + 128 * ai + 16 * m; float s = 0.f;
#pragma unroll
                for (int bj = 0; bj < 2; ++bj) {
                    const f32x4 v0 = acc[ai][bj][m][0], v1 = acc[ai][bj][m][1];
                    float* p = Y + (size_t)row * 1024 + col0 + 128 * bj;
                    *(f32x4*)p = v0; *(f32x4*)(p + 4) = v1;
                    s += (v0[0] * v0[0] + v0[1] * v0[1]) + (v0[2] * v0[2] + v0[3] * v0[3]) + (v1[0] * v1[0] + v1[1] * v1[1]) + (v1[2] * v1[2] + v1[3] * v1[3]);
                }
                s += __shfl_xor(s, 16); s += __shfl_xor(s, 32);
                if (fq == 0) atomicAdd(SSQ + row, s);
            }
    }
};

struct EpiOut {
    static constexpr bool AFTER_DRAIN = true;
    const float* X; float* OUT; const float* MOD; const float* PG; float* xbuf; unsigned* cnt;
    DI void operator()(const f32x4 (&)[2][2][4][2], const pg8::Unit&, int, int, int, int) const {}
    DI void fused(f32x4 (&acc)[2][2][4][2], const pg8::Unit& u, int wr, int wc, int fr, int fq, LAS unsigned char* lds, int wid, int lane) const {
        LAS float* Pp = (LAS float*)lds;
        LAS float* Sr = (LAS float*)(lds + 4096);
        const int tid = wid * 64 + lane;
        const int row0 = u.pm * 256 + wr * 64 + fr, col0 = u.pn * 256 + 32 * wc + 8 * fq;
#pragma unroll
        for (int ai = 0; ai < 2; ++ai)
#pragma unroll
            for (int m = 0; m < 4; ++m) {
                float s = 0.f;
#pragma unroll
                for (int bj = 0; bj < 2; ++bj)
#pragma unroll
                    for (int n = 0; n < 2; ++n) { const f32x4 v = acc[ai][bj][m][n]; s += (v[0] * v[0] + v[1] * v[1]) + (v[2] * v[2] + v[3] * v[3]); }
                s += __shfl_xor(s, 16); s += __shfl_xor(s, 32);
                if (fq == 0) Pp[(ai * 128 + wr * 64 + m * 16 + fr) * 4 + wc] = s;
            }
        asm volatile("s_waitcnt lgkmcnt(0)" ::: "memory"); __builtin_amdgcn_s_barrier(); asm volatile("" ::: "memory");
        {
            const float* gt = MOD + (u.pm >> 5) * 3072 + 2048;
#pragma unroll
            for (int bj = 0; bj < 2; ++bj)
#pragma unroll
                for (int n = 0; n < 2; ++n) { const f32x4 gpv = *(const f32x4*)(gt + col0 + 128 * bj + 4 * n) * *(const f32x4*)(PG + col0 + 128 * bj + 4 * n);
#pragma unroll
                    for (int ai = 0; ai < 2; ++ai)
#pragma unroll
                        for (int m = 0; m < 4; ++m) acc[ai][bj][m][n] *= gpv; }
        }
        f32x4 preA[2][2][2], preB[2][2][2];
#define EPO_LOAD(pre, ai_, mp_) do { _Pragma("unroll") for (int mm = 0; mm < 2; ++mm) _Pragma("unroll") for (int bj = 0; bj < 2; ++bj) { \
            const float* p_ = X + (size_t)(row0 + 128 * (ai_) + 16 * (2 * (mp_) + mm)) * 1024 + col0 + 128 * bj; pre[mm][bj][0] = *(const f32x4*)p_; pre[mm][bj][1] = *(const f32x4*)(p_ + 4); } } while (0)
#define EPO_STORE(pre, ai_, mp_) do { _Pragma("unroll") for (int mm = 0; mm < 2; ++mm) { const int m_ = 2 * (mp_) + mm; const float rs_ = Sr[128 * (ai_) + wr * 64 + m_ * 16 + fr]; \
            _Pragma("unroll") for (int bj = 0; bj < 2; ++bj) { float* o_ = OUT + (size_t)(row0 + 128 * (ai_) + 16 * m_) * 1024 + col0 + 128 * bj; \
                *(f32x4*)o_ = pre[mm][bj][0] + acc[ai_][bj][m_][0] * rs_; *(f32x4*)(o_ + 4) = pre[mm][bj][1] + acc[ai_][bj][m_][1] * rs_; } } \
            asm volatile("" ::: "memory"); } while (0)
        EPO_LOAD(preA, 0, 0);
        if (tid < 256) { const float s = (Pp[tid * 4] + Pp[tid * 4 + 1]) + (Pp[tid * 4 + 2] + Pp[tid * 4 + 3]);
            __hip_atomic_store(xbuf + (size_t)((u.pm * 4 + u.pn) * 256 + tid), s, __ATOMIC_RELAXED, __HIP_MEMORY_SCOPE_AGENT); }
        asm volatile("s_waitcnt vmcnt(0)" ::: "memory");
        if (wid < 4 && lane == 0) __hip_atomic_fetch_add(cnt + 64 * u.pm, 1u, __ATOMIC_RELAXED, __HIP_MEMORY_SCOPE_AGENT);
        if (wid == 0) {
            unsigned sp = 0;
            while ((unsigned)__builtin_amdgcn_readfirstlane(__hip_atomic_load(cnt + 64 * u.pm, __ATOMIC_RELAXED, __HIP_MEMORY_SCOPE_AGENT)) < 16u) { __builtin_amdgcn_s_sleep(2); if (++sp > (1u << 22)) break; }
            __builtin_amdgcn_fence(__ATOMIC_ACQUIRE, "agent");
        }
        asm volatile("s_waitcnt vmcnt(0) lgkmcnt(0)" ::: "memory"); __builtin_amdgcn_s_barrier(); asm volatile("" ::: "memory");
        if (tid < 256) { float t = 0.f;
#pragma unroll
            for (int p = 0; p < 4; ++p) t += __hip_atomic_load(xbuf + (size_t)((u.pm * 4 + p) * 256 + tid), __ATOMIC_RELAXED, __HIP_MEMORY_SCOPE_AGENT);
            Sr[tid] = 1.0f / sqrtf(t * (1.0f / 1024.0f) + 1e-6f); }
        asm volatile("s_waitcnt vmcnt(0) lgkmcnt(0)" ::: "memory"); __builtin_amdgcn_s_barrier(); asm volatile("" ::: "memory");
        EPO_LOAD(preB, 0, 1); EPO_STORE(preA, 0, 0); EPO_LOAD(preA, 1, 0); EPO_STORE(preB, 0, 1); EPO_LOAD(preB, 1, 1); EPO_STORE(preA, 1, 0); EPO_STORE(preB, 1, 1);
#undef EPO_LOAD
#undef EPO_STORE
    }
};

DI void transpose_item(const float* W, int ldw, int k0, int srccol4, bf16_t* WT, int ldk, int kd0, int drow0, LAS float* scr, int lane) {
    f32x4 tv[8];
    const int ng = lane & 7, kr = lane >> 3;
    const float* wp = W + (size_t)(k0 + kr) * ldw + srccol4;
#pragma unroll
    for (int i = 0; i < 8; ++i) tv[i] = __builtin_nontemporal_load((const f32x4*)(wp + (size_t)(8 * i) * ldw));
#pragma unroll
    for (int i = 0; i < 8; ++i) { LAS float* d = scr + (kr + 8 * i) * 33 + 4 * ng; d[0] = tv[i][0]; d[1] = tv[i][1]; d[2] = tv[i][2]; d[3] = tv[i][3]; }
    asm volatile("s_waitcnt lgkmcnt(0)" ::: "memory");
    const int c = lane & 7;
#pragma unroll
    for (int j = 0; j < 4; ++j) {
        const int n = (lane >> 3) + 8 * j; const LAS float* s = scr + (8 * c) * 33 + n;
        u32x4 o; o.x = pk2(s[0 * 33], s[1 * 33]); o.y = pk2(s[2 * 33], s[3 * 33]); o.z = pk2(s[4 * 33], s[5 * 33]); o.w = pk2(s[6 * 33], s[7 * 33]);
        *(u32x4*)(WT + (size_t)(drow0 + n) * ldk + kd0 + 8 * c) = o;
    }
    asm volatile("s_waitcnt lgkmcnt(0)" ::: "memory");
}

DI void phase0(const Params& P, LAS unsigned char* lds) {
    const int tid = threadIdx.x, lane = tid & 63, wave = __builtin_amdgcn_readfirstlane(tid >> 6), bx = blockIdx.x;
    const int gw = bx * 8 + wave, NGW = gridDim.x * 8, gtid = bx * 512 + tid, NT = gridDim.x * 512;
    unsigned char* ws = P.ws;
    for (int i = gtid; i < 64; i += NT) ((unsigned*)(ws + WS_CNT))[64 * i] = 0u;
    float* roper = (float*)(ws + WS_ROPER); float* ropec = (float*)(ws + WS_ROPEC);
    for (int i = gtid; i < (128 + 64) * 16; i += NT) {
        const int pos = i >> 4, f = i & 15; const float inv = powf(10000.0f, -(float)(2 * f) / 32.0f);
        if (pos < 128) { const float ang = (float)pos * inv; roper[pos * 32 + f] = cosf(ang); roper[pos * 32 + 16 + f] = sinf(ang); }
        else { const int p = pos - 128; const float ang = (float)p * inv; ropec[p * 32 + f] = cosf(ang); ropec[p * 32 + 16 + f] = sinf(ang); }
    }
    {
        bf16_t* BT = (bf16_t*)(ws + WS_BT); const float* rpb = P.in[11];
        const int total8 = NH * BT_VARS * BT_BLKS * 128;
        for (int e8 = gtid; e8 < total8; e8 += NT) {
            const int ln = e8 & 63, half = (e8 >> 6) & 1, rest = e8 >> 7, blk = rest % BT_BLKS, rest2 = rest / BT_BLKS, var = rest2 % BT_VARS, h = rest2 / BT_VARS;
            const int qi = ln & 31, hi = ln >> 5;
            const int rv = var / 3, cv = var % 3;
            const int r0 = rv == 0 ? 0 : (rv == 1 ? 2 : (rv == 2 ? 4 : (rv == 3 ? 124 : 126)));
            const int cbv = cv == 0 ? 0 : (cv == 1 ? 1 : 3), kc0 = cv == 0 ? 0 : (cv == 1 ? 8 : 32);
            const int rq = r0 + (qi >> 4), c = 16 * cbv + (qi & 15);
            const int rs0 = iclip(r0 - 4, 0, 120), rsq = iclip(rq - 4, 0, 120), kr = rs0 + blk, cs = iclip(c - 8, 0, 48);
            const bool rowok = (kr >= rsq) && (kr < rsq + 8);
            const float* rp = rpb + (h * 15 + (rowok ? kr - rq + 7 : 0)) * 31 - c + 15;
            float v[8];
#pragma unroll
            for (int i = 0; i < 8; ++i) { const int kc = kc0 + swap23(crow(8 * half + i, hi)); const bool valid = rowok && (kc >= cs) && (kc < cs + 16); const float t = rp[valid ? kc : c] * LOG2E; v[i] = valid ? t : -1.0e30f; }
            u32x4 o; o.x = pk2(v[0], v[1]); o.y = pk2(v[2], v[3]); o.z = pk2(v[4], v[5]); o.w = pk2(v[6], v[7]);
            *(u32x4*)(BT + (size_t)e8 * 8) = o;
        }
    }
    if (bx < 96) {
        LAS float* s = (LAS float*)lds;
        for (int i = tid; i < 3072; i += 512) { const int v = i >> 10, k = i & 1023; const float x = v < 2 ? P.in[1][v * 1024 + k] : P.in[3][k]; s[i] = x / (1.0f + expf(-x)); }
        __syncthreads();
        const float* wm = P.in[4]; const int col = bx * 32 + (lane & 31), rsub = lane >> 5;
        float a0 = 0.f, a1 = 0.f, a2 = 0.f;
#pragma unroll 16
        for (int it = 0; it < 64; ++it) { const int k = wave * 128 + it * 2 + rsub; const float w = wm[(size_t)k * 3072 + col]; a0 += s[k] * w; a1 += s[1024 + k] * w; a2 += s[2048 + k] * w; }
        a0 += __shfl_xor(a0, 32); a1 += __shfl_xor(a1, 32); a2 += __shfl_xor(a2, 32);
        LAS float* red = s + 3072;
        if (lane < 32) { red[(wave * 3 + 0) * 32 + lane] = a0; red[(wave * 3 + 1) * 32 + lane] = a1; red[(wave * 3 + 2) * 32 + lane] = a2; }
        __syncthreads();
        if (tid < 96) { const int v = tid >> 5, cl = tid & 31; float sum = 0.f;
#pragma unroll
            for (int w = 0; w < 8; ++w) sum += red[(w * 3 + v) * 32 + cl];
            ((float*)(ws + WS_MOD))[v * 3072 + bx * 32 + cl] = sum + P.in[5][bx * 32 + cl]; }
        __syncthreads();
    }
    {
        LAS float* scr = (LAS float*)(lds + wave * 16384);
        bf16_t* WT = (bf16_t*)(ws + WS_WTIN);
        for (int it = NGW - 1 - gw; it < 320 * 16; it += NGW) {
            const int G = it >> 4, kb = it & 15;
            transpose_item(P.in[8], INC, 64 * kb, wtin_src_col(32 * G + 4 * (lane & 7)), WT, 1024, 64 * kb, 32 * G, scr, lane);
        }
    }
}

DI void phase1(const Params& P) {
    const int tid = threadIdx.x, lane = tid & 63, wave = tid >> 6, gw = blockIdx.x * 8 + wave, NGW = gridDim.x * 8;
    unsigned char* ws = P.ws; const float* MOD = (const float*)(ws + WS_MOD); const float* g = P.in[6];
    const int NROW = MTOK;
    const bool xa = (gridDim.x == 256);
    const int rbase = xa ? 2048 * (int)(blockIdx.x & 7) + (int)(blockIdx.x >> 3) * 8 + wave : gw, rstep = xa ? 256 : NGW, nk = xa ? 8 : (NROW - gw + NGW - 1) / NGW;
    f32x4 xn[4], cA[4], cB[4]; int vcur = -1;
    if (nk > 0) { const f32x4* xr = (const f32x4*)(P.in[0] + (size_t)rbase * DM) + lane;
#pragma unroll
        for (int j = 0; j < 4; ++j) xn[j] = __builtin_nontemporal_load(xr + 64 * j); }
    for (int k = 0; k < nk; ++k) {
        const int m = rbase + rstep * k;
        bf16_t* dst = (bf16_t*)(ws + WS_H) + (size_t)m * DM; const int v = m >> 13;
        f32x4 x[4];
#pragma unroll
        for (int j = 0; j < 4; ++j) x[j] = xn[j];
        if (k + 1 < nk) { const f32x4* xr = (const f32x4*)(P.in[0] + (size_t)(m + rstep) * DM) + lane;
#pragma unroll
            for (int j = 0; j < 4; ++j) xn[j] = __builtin_nontemporal_load(xr + 64 * j); }
        float ss = 0.f;
#pragma unroll
        for (int j = 0; j < 4; ++j) ss += (x[j][0] * x[j][0] + x[j][1] * x[j][1]) + (x[j][2] * x[j][2] + x[j][3] * x[j][3]);
        const float rstd = 1.0f / sqrtf(wave_sum(ss) * (1.0f / DM) + 1e-6f);
        if (v != vcur) {
            vcur = v;
            const f32x4* sh = (const f32x4*)(MOD + v * 3072) + lane; const f32x4* sc = (const f32x4*)(MOD + v * 3072 + 1024) + lane; const f32x4* gg = (const f32x4*)g + lane;
#pragma unroll
            for (int j = 0; j < 4; ++j) { const f32x4 b = sc[64 * j], c = gg[64 * j]; cB[j] = sh[64 * j];
#pragma unroll
                for (int e = 0; e < 4; ++e) cA[j][e] = c[e] * (1.0f + b[e]); }
        }
        u32x2* o = (u32x2*)dst + lane;
#pragma unroll
        for (int j = 0; j < 4; ++j) {
            f32x4 h;
#pragma unroll
            for (int e = 0; e < 4; ++e) h[e] = (x[j][e] * rstd) * cA[j][e] + cB[j][e];
            u32x2 w; w.x = pk2(h[0], h[1]); w.y = pk2(h[2], h[3]); o[64 * j] = w;
        }
    }
}

DI void ctx_kv(const Params& P, LAS unsigned char* lds) {
    const int tid = threadIdx.x, lane = tid & 63, wave = __builtin_amdgcn_readfirstlane(tid >> 6), bx = blockIdx.x;
    unsigned char* ws = P.ws;
    const bf16_t* WT = (const bf16_t*)(ws + WS_WTIN); const float* MOD = (const float*)(ws + WS_MOD) + 2 * 3072; const float* g = P.in[6];
    bf16_t* KC = (bf16_t*)(ws + WS_KC); bf16_t* VTC = (bf16_t*)(ws + WS_VTC);
    const int r = lane & 31, hi = lane >> 5;
    constexpr int HROW = 2064;
    for (int blk = bx; blk < 256; blk += gridDim.x) {
        const int rb = blk >> 4, cbk = (blk & 15) * 4 + (wave & 3), kh = wave >> 2;
        const int wrow = (cbk < 32 ? 5120 : 9216 - 1024) + 32 * cbk + r;
        const bf16_t* bp = WT + (size_t)wrow * DM + kh * 512 + 8 * hi;
        bf16x8 Bf[32];
#pragma unroll
        for (int k = 0; k < 32; ++k) Bf[k] = *(const bf16x8*)(bp + 16 * k);
        f32x4 xa[4][4];
#pragma unroll
        for (int rr = 0; rr < 4; ++rr) { const f32x4* xr = (const f32x4*)(P.in[2] + (size_t)(32 * rb + 4 * wave + rr) * DM) + lane;
#pragma unroll
            for (int j = 0; j < 4; ++j) xa[rr][j] = xr[64 * j]; }
#pragma unroll
        for (int rr = 0; rr < 4; ++rr) {
            const int row = 4 * wave + rr;
            f32x4 x[4]; float ss = 0.f;
#pragma unroll
            for (int j = 0; j < 4; ++j) { x[j] = xa[rr][j]; ss += (x[j][0] * x[j][0] + x[j][1] * x[j][1]) + (x[j][2] * x[j][2] + x[j][3] * x[j][3]); }
            const float rstd = 1.0f / sqrtf(wave_sum(ss) * (1.0f / DM) + 1e-6f);
            const f32x4* sh = (const f32x4*)MOD + lane; const f32x4* sc = (const f32x4*)(MOD + 1024) + lane; const f32x4* gg = (const f32x4*)g + lane;
#pragma unroll
            for (int j = 0; j < 4; ++j) {
                const f32x4 a = sh[64 * j], b = sc[64 * j], c = gg[64 * j]; f32x4 h;
#pragma unroll
                for (int e = 0; e < 4; ++e) h[e] = (x[j][e] * rstd) * c[e] * (1.0f + b[e]) + a[e];
                u32x2 w; w.x = pk2(h[0], h[1]); w.y = pk2(h[2], h[3]);
                *(LAS u32x2*)(lds + row * HROW + (lane + 64 * j) * 8) = w;
            }
        }
        __syncthreads();
        const LAS unsigned char* ap = lds + r * HROW + (kh * 512 + 8 * hi) * 2;
        f32x16 acc = {0.f, 0.f, 0.f, 0.f, 0.f, 0.f, 0.f, 0.f, 0.f, 0.f, 0.f, 0.f, 0.f, 0.f, 0.f, 0.f};
#pragma unroll
        for (int k = 0; k < 32; ++k) {
            const bf16x8 a = *(const LAS bf16x8*)(ap + 32 * k);
            acc = __builtin_amdgcn_mfma_f32_32x32x16_bf16(a, Bf[k], acc, 0, 0, 0);
        }
        LAS float* red = (LAS float*)(lds + 32 * HROW) + ((wave & 3) * 64 + lane) * 16;
        if (kh == 1) {
#pragma unroll
            for (int i = 0; i < 16; ++i) red[i] = acc[i];
        }
        __syncthreads();
        if (kh == 0) {
#pragma unroll
            for (int i = 0; i < 16; ++i) acc[i] += red[i];
            if (cbk < 32) {
                const int c = 32 * cbk + r, head = c >> 6, d = c & 63, e = d & 31, pos = (d & 32) + 8 * ((e & 15) >> 2) + 4 * (e >> 4) + (e & 3);
#pragma unroll
                for (int i = 0; i < 16; ++i) { const int row = 32 * rb + crow(i, hi); KC[(size_t)row * DM + head * 64 + pos] = (bf16_t)(pk2(acc[i], 0.f) & 0xffffu); }
            } else {
                const int c = 32 * (cbk - 32) + r;
#pragma unroll
                for (int g2 = 0; g2 < 4; ++g2) {
                    const int row = 32 * rb + 8 * g2 + 4 * hi; const int b = row >> 8, key = row & 255;
                    u32x2 w; w.x = pk2(acc[4 * g2], acc[4 * g2 + 1]); w.y = pk2(acc[4 * g2 + 2], acc[4 * g2 + 3]);
                    *(u32x2*)(VTC + ((size_t)(b * 1024 + c)) * CTX + key) = w;
                }
            }
        }
        __syncthreads();
    }
}

DI void softmax_step(f32x16& S, float& mrun, float& lrun, f32x16 (&O)[2], bf16x8 (&Pf)[2]) {
    float bm = fmaxf(fmaxf(S[0], S[1]), fmaxf(S[2], S[3]));
#pragma unroll
    for (int r = 4; r < 16; r += 4) bm = fmaxf(bm, fmaxf(fmaxf(S[r], S[r + 1]), fmaxf(S[r + 2], S[r + 3])));
    bm = fmaxf(bm, __shfl_xor(bm, 32));
    if (__any(bm > mrun + 8.0f)) {
        const float mn = fmaxf(mrun, bm), alpha = __builtin_amdgcn_exp2f(mrun - mn);
        lrun *= alpha; mrun = mn;
#pragma unroll
        for (int r = 0; r < 16; ++r) { O[0][r] *= alpha; O[1][r] *= alpha; }
    }
    float ls0 = 0.f, ls1 = 0.f;
#pragma unroll
    for (int r = 0; r < 16; r += 2) { S[r] = __builtin_amdgcn_exp2f(S[r] - mrun); S[r + 1] = __builtin_amdgcn_exp2f(S[r + 1] - mrun); ls0 += S[r]; ls1 += S[r + 1]; }
    lrun += ls0 + ls1;
#pragma unroll
    for (int s = 0; s < 2; ++s) {
        u32x4 p; p.x = pk2(S[8 * s], S[8 * s + 1]); p.y = pk2(S[8 * s + 2], S[8 * s + 3]); p.z = pk2(S[8 * s + 4], S[8 * s + 5]); p.w = pk2(S[8 * s + 6], S[8 * s + 7]);
        Pf[s] = __builtin_bit_cast(bf16x8, p);
    }
}
DI void softmax_step2(f32x16& S0, f32x16& S1, float& mrun, float& lrun, f32x16 (&O)[2], bf16x8 (&P0)[2], bf16x8 (&P1)[2]) {
    float bm = fmaxf(fmaxf(S0[0], S0[1]), fmaxf(S1[0], S1[1]));
#pragma unroll
    for (int r = 2; r < 16; r += 2) bm = fmaxf(bm, fmaxf(fmaxf(S0[r], S0[r + 1]), fmaxf(S1[r], S1[r + 1])));
    bm = fmaxf(bm, __shfl_xor(bm, 32));
    if (__any(bm > mrun + 8.0f)) {
        const float mn = fmaxf(mrun, bm), alpha = __builtin_amdgcn_exp2f(mrun - mn);
        lrun *= alpha; mrun = mn;
#pragma unroll
        for (int r = 0; r < 16; ++r) { O[0][r] *= alpha; O[1][r] *= alpha; }
    }
    float ls0 = 0.f, ls1 = 0.f;
#pragma unroll
    for (int r = 0; r < 16; ++r) { S0[r] = __builtin_amdgcn_exp2f(S0[r] - mrun); S1[r] = __builtin_amdgcn_exp2f(S1[r] - mrun); ls0 += S0[r]; ls1 += S1[r]; }
    lrun += ls0 + ls1;
#pragma unroll
    for (int s = 0; s < 2; ++s) {
        u32x4 p; p.x = pk2(S0[8 * s], S0[8 * s + 1]); p.y = pk2(S0[8 * s + 2], S0[8 * s + 3]); p.z = pk2(S0[8 * s + 4], S0[8 * s + 5]); p.w = pk2(S0[8 * s + 6], S0[8 * s + 7]);
        P0[s] = __builtin_bit_cast(bf16x8, p);
        u32x4 q; q.x = pk2(S1[8 * s], S1[8 * s + 1]); q.y = pk2(S1[8 * s + 2], S1[8 * s + 3]); q.z = pk2(S1[8 * s + 4], S1[8 * s + 5]); q.w = pk2(S1[8 * s + 6], S1[8 * s + 7]);
        P1[s] = __builtin_bit_cast(bf16x8, q);
    }
}
constexpr int AT_KCS = 0, AT_KROW = 144, AT_VCS = 36864, AT_VROW = 528, AT_BTS = 70656;
DI void attn_phase(const Params& P, LAS unsigned char* lds, const bool do_store) {
    const int tid = threadIdx.x, lane = tid & 63, wave = tid >> 6, bx = blockIdx.x, G = gridDim.x;
    unsigned char* ws = P.ws;
    bf16_t* A2 = (bf16_t*)(ws + WS_A2); const bf16_t* KB = (const bf16_t*)(ws + WS_KB); const bf16_t* VT = (const bf16_t*)(ws + WS_VT);
    const bf16_t* KC = (const bf16_t*)(ws + WS_KC); const bf16_t* VTC = (const bf16_t*)(ws + WS_VTC); const bf16_t* SZB = (const bf16_t*)(ws + WS_SZB);
    const bf16_t* BT = (const bf16_t*)(ws + WS_BT);
    const int vcu = (G % 8 == 0) ? (bx % 8) * (G / 8) + bx / 8 : bx;
    const int qi = lane & 31, hi = lane >> 5, kperm = swap23(qi);
    for (int bi = vcu; bi < 256; bi += G) {
        const int rhalf = bi & 1, cb = (bi >> 1) & 3, bh = bi >> 3, b = bh >> 4, h = bh & 15;
        const int c0 = 16 * cb, kc0 = cb == 0 ? 0 : (cb == 1 ? 8 : (cb == 2 ? 24 : 32)), cv = cb == 0 ? 0 : (cb == 3 ? 2 : 1);
        {
            const bf16_t* ksrc = KC + (size_t)(b * CTX) * DM + h * 64;
#pragma unroll
            for (int i = 0; i < 4; ++i) { const int c = tid + 512 * i, row = c >> 3, ch = c & 7;
                *(LAS u32x4*)(lds + AT_KCS + row * AT_KROW + ch * 16) = *(const u32x4*)(ksrc + (size_t)row * DM + ch * 8); }
            const bf16_t* vsrc = VTC + (size_t)((b * NH + h) * 64) * CTX;
#pragma unroll
            for (int i = 0; i < 4; ++i) { const int c = tid + 512 * i, row = c >> 5, ch = c & 31;
                *(LAS u32x4*)(lds + AT_VCS + row * AT_VROW + ch * 16) = *(const u32x4*)(vsrc + (size_t)row * CTX + ch * 8); }
            const bf16_t* bsrc = BT + ((size_t)((h * BT_VARS + 6 + cv) * BT_BLKS)) * 1024;
            for (int c = tid; c < 1152; c += 512) {
                const u32x4 v = *(const u32x4*)(bsrc + c * 8);
                const int kbq = c >> 7, half = (c >> 6) & 1, ln = c & 63;
                LAS float* d = (LAS float*)(lds + AT_BTS + kbq * 4096 + (2 * half) * 1024 + ln * 16);
                f32x4 lo4 = {bflo(v.x), bfhi(v.x), bflo(v.y), bfhi(v.y)}, hi4 = {bflo(v.z), bfhi(v.z), bflo(v.w), bfhi(v.w)};
                *(LAS f32x4*)d = lo4; *(LAS f32x4*)(d + 256) = hi4;
            }
        }
        __syncthreads();
        const LAS unsigned char* kcl = lds + AT_KCS + kperm * AT_KROW + 16 * hi;
        const LAS unsigned char* vcl = lds + AT_VCS + qi * AT_VROW + 16 * hi;
        const LAS unsigned char* btl = lds + AT_BTS + lane * 16;
#pragma unroll 1
        for (int j = 0; j < 4; ++j) {
            const int rp = rhalf * 32 + wave + 8 * j, r0 = 2 * rp, rs0 = iclip(r0 - 4, 0, 120);
            const int rv = r0 == 0 ? 0 : (r0 == 2 ? 1 : (r0 == 124 ? 3 : (r0 == 126 ? 4 : 2)));
            const int tq = (r0 + (qi >> 4)) * 64 + c0 + (qi & 15);
            const size_t qoff = ((size_t)(b * SEQ + tq)) * 2048 + 1024 + h * 64;
            bf16x8 Qf[4];
#pragma unroll
            for (int d0 = 0; d0 < 4; ++d0) Qf[d0] = *(const bf16x8*)(A2 + qoff + 16 * d0 + 8 * hi);
            const bf16_t* knp = KB + (size_t)(b * NH + h) * 524288 + ((kc0 + kperm) >> 3) * 512 + hi * 64 + ((kc0 + kperm) & 7) * 8;
            const bf16_t* vnp = VT + (size_t)(b * NH + h) * 524288 + ((kc0 >> 3) + hi) * 512 + qi * 8;
            const bf16_t* btg = BT + ((size_t)((h * BT_VARS + rv * 3 + cv) * BT_BLKS)) * 1024 + lane * 8;
            bf16x8 Kn[4], Kn2[4], Vn[4];
            {
                const int krow = rs0, krow1 = min(rs0 + 1, 127);
#pragma unroll
                for (int d0 = 0; d0 < 4; ++d0) { Kn[d0] = *(const bf16x8*)(knp + (size_t)krow * 4096 + 128 * d0); Kn2[d0] = *(const bf16x8*)(knp + (size_t)krow1 * 4096 + 128 * d0); }
#pragma unroll
                for (int x = 0; x < 4; ++x) Vn[x] = *(const bf16x8*)(vnp + (size_t)krow * 4096 + 1024 * (x & 1) + 256 * (x >> 1));
            }
            f32x16 O[2];
#pragma unroll
            for (int r = 0; r < 16; ++r) { O[0][r] = 0.f; O[1][r] = 0.f; }
            float mrun = -1.0e30f, lrun = 0.f;
#pragma unroll 1
            for (int jp = 0; jp < 4; ++jp) {
                bf16x8 Ka[4], Kb[4];
#pragma unroll
                for (int d0 = 0; d0 < 4; ++d0) { Ka[d0] = *(const LAS bf16x8*)(kcl + (64 * jp) * AT_KROW + 32 * d0); Kb[d0] = *(const LAS bf16x8*)(kcl + (64 * jp + 32) * AT_KROW + 32 * d0); }
                f32x16 S0, S1;
#pragma unroll
                for (int r = 0; r < 16; ++r) { S0[r] = 0.f; S1[r] = 0.f; }
#pragma unroll
                for (int d0 = 0; d0 < 4; ++d0) { S0 = __builtin_amdgcn_mfma_f32_32x32x16_bf16(Ka[d0], Qf[d0], S0, 0, 0, 0); S1 = __builtin_amdgcn_mfma_f32_32x32x16_bf16(Kb[d0], Qf[d0], S1, 0, 0, 0); }
                bf16x8 Va[4], Vb[4];
#pragma unroll
                for (int x = 0; x < 4; ++x) { Va[x] = *(const LAS bf16x8*)(vcl + (32 * (x >> 1)) * AT_VROW + 128 * jp + 32 * (x & 1)); Vb[x] = *(const LAS bf16x8*)(vcl + (32 * (x >> 1)) * AT_VROW + 128 * jp + 64 + 32 * (x & 1)); }
                bf16x8 Pa[2], Pb[2];
                softmax_step2(S0, S1, mrun, lrun, O, Pa, Pb);
#pragma unroll
                for (int x = 0; x < 4; ++x) { O[x >> 1] = __builtin_amdgcn_mfma_f32_32x32x16_bf16(Va[x], Pa[x & 1], O[x >> 1], 0, 0, 0); O[x >> 1] = __builtin_amdgcn_mfma_f32_32x32x16_bf16(Vb[x], Pb[x & 1], O[x >> 1], 0, 0, 0); }
            }
            const bf16_t* zp = SZB + ((size_t)(b * SEQ + tq)) * DM + h * 64 + 4 * hi;
            u32x2 zz[8];
#pragma unroll
            for (int i = 0; i < 8; ++i) zz[i] = *(const u32x2*)(zp + 8 * i);
#pragma unroll
            for (int kb = 0; kb < 9; ++kb) {
                bf16x8 Kf[4], Vf[4];
#pragma unroll
                for (int d0 = 0; d0 < 4; ++d0) Kf[d0] = Kn[d0];
#pragma unroll
                for (int x = 0; x < 4; ++x) Vf[x] = Vn[x];
#pragma unroll
                for (int d0 = 0; d0 < 4; ++d0) Kn[d0] = Kn2[d0];
                if (kb < 7) {
                    const int krow2 = min(rs0 + kb + 2, 127);
#pragma unroll
                    for (int d0 = 0; d0 < 4; ++d0) Kn2[d0] = *(const bf16x8*)(knp + (size_t)krow2 * 4096 + 128 * d0);
                }
                if (kb < 8) {
                    const int krow = min(rs0 + kb + 1, 127);
#pragma unroll
                    for (int x = 0; x < 4; ++x) Vn[x] = *(const bf16x8*)(vnp + (size_t)krow * 4096 + 1024 * (x & 1) + 256 * (x >> 1));
                }
                f32x16 S;
                if (rv == 2) {
#pragma unroll
                    for (int q = 0; q < 4; ++q) { const f32x4 t4 = *(const LAS f32x4*)(btl + kb * 4096 + q * 1024); S[4 * q] = t4[0]; S[4 * q + 1] = t4[1]; S[4 * q + 2] = t4[2]; S[4 * q + 3] = t4[3]; }
                } else {
                    const u32x4 b0 = *(const u32x4*)(btg + kb * 1024), b1 = *(const u32x4*)(btg + kb * 1024 + 512);
                    S[0] = bflo(b0.x); S[1] = bfhi(b0.x); S[2] = bflo(b0.y); S[3] = bfhi(b0.y); S[4] = bflo(b0.z); S[5] = bfhi(b0.z); S[6] = bflo(b0.w); S[7] = bfhi(b0.w);
                    S[8] = bflo(b1.x); S[9] = bfhi(b1.x); S[10] = bflo(b1.y); S[11] = bfhi(b1.y); S[12] = bflo(b1.z); S[13] = bfhi(b1.z); S[14] = bflo(b1.w); S[15] = bfhi(b1.w);
                }
#pragma unroll
                for (int d0 = 0; d0 < 4; ++d0) S = __builtin_amdgcn_mfma_f32_32x32x16_bf16(Kf[d0], Qf[d0], S, 0, 0, 0);
                bf16x8 Pf[2];
                softmax_step(S, mrun, lrun, O, Pf);
#pragma unroll
                for (int x = 0; x < 4; ++x) O[x >> 1] = __builtin_amdgcn_mfma_f32_32x32x16_bf16(Vf[x], Pf[x & 1], O[x >> 1], 0, 0, 0);
            }
            const float ltot = lrun + __shfl_xor(lrun, 32), inv = 1.0f / ltot;
            bf16_t* op = A2 + qoff + 8 * hi;
#pragma unroll
            for (int blk = 0; blk < 2; ++blk)
#pragma unroll
                for (int gp = 0; gp < 2; ++gp) {
                    u32x2 w[2];
#pragma unroll
                    for (int q = 0; q < 2; ++q) { const int g = 2 * gp + q; const u32x2 z = zz[4 * blk + g];
                        w[q].x = pk2(O[blk][4 * g] * inv * bflo(z.x), O[blk][4 * g + 1] * inv * bfhi(z.x)); w[q].y = pk2(O[blk][4 * g + 2] * inv * bflo(z.y), O[blk][4 * g + 3] * inv * bfhi(z.y)); }
                    const auto s0 = __builtin_amdgcn_permlane32_swap(w[0].x, w[1].x, false, false);
                    const auto s1 = __builtin_amdgcn_permlane32_swap(w[0].y, w[1].y, false, false);
                    u32x4 o; o.x = s0[0]; o.y = s1[0]; o.z = s0[1]; o.w = s1[1];
                    if (do_store) *(u32x4*)(op + 32 * blk + 16 * gp) = o;
                }
        }
        __syncthreads();
    }
}

DI void conv_fixup(const Params& P) {
    const int gtid = blockIdx.x * 512 + threadIdx.x, NT = gridDim.x * 512;
    unsigned char* ws = P.ws; bf16_t* A2 = (bf16_t*)(ws + WS_A2); const float* EDGE = (const float*)(ws + WS_EDGE); const float* cw = P.in[9];
    for (int i = gtid; i < 62 * 2 * 128; i += NT) {
        const int c8 = (i & 127) * 8, which = (i >> 7) & 1, bi = i >> 8;
        const int pm = bi < 31 ? bi + 1 : bi + 2;
        const size_t row = which == 0 ? (size_t)256 * pm : (size_t)256 * pm - 1;
        const float* gzp = EDGE + (size_t)((which == 0 ? pm : pm - 1) * 4 + (which == 0 ? 2 : 3)) * 1024 + c8;
        const float* cxp = EDGE + (size_t)((which == 0 ? pm - 1 : pm) * 4 + (which == 0 ? 1 : 0)) * 1024 + c8;
        const float* wp = cw + (which == 0 ? 0 : 2048) + c8;
        u32x4 v = *(const u32x4*)(A2 + row * 2048 + c8); unsigned va[4] = {v.x, v.y, v.z, v.w};
#pragma unroll
        for (int e = 0; e < 4; ++e) va[e] = pk2(bflo(va[e]) + gzp[2 * e] * wp[2 * e] * cxp[2 * e], bfhi(va[e]) + gzp[2 * e + 1] * wp[2 * e + 1] * cxp[2 * e + 1]);
        v.x = va[0]; v.y = va[1]; v.z = va[2]; v.w = va[3];
        *(u32x4*)(A2 + row * 2048 + c8) = v;
    }
}
DI void outw_phase(const Params& P, LAS unsigned char* lds) {
    const int tid = threadIdx.x, lane = tid & 63, wave = __builtin_amdgcn_readfirstlane(tid >> 6), gw = blockIdx.x * 8 + wave, NGW = gridDim.x * 8;
    unsigned char* ws = P.ws; LAS float* scr = (LAS float*)(lds + wave * 16384);
    bf16_t* W2T = (bf16_t*)(ws + WS_W2T); bf16_t* WOT = (bf16_t*)(ws + WS_WOT);
    for (int it = gw; it < 32 * 32 + 32 * 16; it += NGW) {
        if (it < 1024) { const int G = it >> 5, kb = it & 31; const float* W = kb < 16 ? P.in[12] : P.in[13];
            transpose_item(W, 1024, 64 * (kb & 15), 32 * G + perm32(4 * (lane & 7)), W2T, 2048, 64 * kb, 32 * G, scr, lane); }
        else { const int i2 = it - 1024, G = i2 >> 4, kb = i2 & 15;
            transpose_item(P.in[14], 1024, 64 * kb, 32 * G + perm32(4 * (lane & 7)), WOT, 1024, 64 * kb, 32 * G, scr, lane); }
    }
}

DI void final_phase(const Params& P) {
    const int tid = threadIdx.x, lane = tid & 63, wave = tid >> 6, gw = blockIdx.x * 8 + wave, NGW = gridDim.x * 8;
    unsigned char* ws = P.ws; const float* MOD = (const float*)(ws + WS_MOD); const float* Y = (const float*)(ws + WS_Y); const float* ssq = (const float*)(ws + WS_SSQ);
    const f32x4* pg = (const f32x4*)P.in[7] + lane;
    for (int m = gw; m < MTOK; m += NGW) {
        const int v = m >> 13; const float rstd = 1.0f / sqrtf(ssq[m] * (1.0f / DM) + 1e-6f);
        const f32x4* xr = (const f32x4*)(P.in[0] + (size_t)m * DM) + lane; const f32x4* yr = (const f32x4*)(Y + (size_t)m * DM) + lane;
        const f32x4* gt = (const f32x4*)(MOD + v * 3072 + 2048) + lane; f32x4* o = (f32x4*)(P.out + (size_t)m * DM) + lane;
#pragma unroll
        for (int j = 0; j < 4; ++j) { const f32x4 x = xr[64 * j], y = yr[64 * j], g = gt[64 * j], p = pg[64 * j]; o[64 * j] = x + g * ((y * rstd) * p); }
    }
}

typedef unsigned v4u __attribute__((ext_vector_type(4)));
#define XB_TMO      128
#define XB_XCNT(j)  (256  + 64 * (j))
#define XB_XSUB(j)  (1280 + 64 * (j))
#define XB_XGEN(j)  (2304 + 64 * (j))
#define XB_TOP      3328
#define XB_TOPGEN   3392
#define XCD_BAR_WORDS 3456
#define XB_SPIN_CAP (1u << 18)

__device__ __forceinline__ unsigned xb_ld(unsigned* p)              { return __hip_atomic_load(p, __ATOMIC_RELAXED, __HIP_MEMORY_SCOPE_AGENT); }
__device__ __forceinline__ unsigned xb_add(unsigned* p, unsigned v) { return __hip_atomic_fetch_add(p, v, __ATOMIC_RELAXED, __HIP_MEMORY_SCOPE_AGENT); }
__device__ __forceinline__ unsigned xb_xcc_id() { return (unsigned)__builtin_amdgcn_s_getreg((3 << 11) | 20) & 0xFu; }
#define XB_SPIN(cond, bar) do { unsigned _sp = 0; while (cond) { __builtin_amdgcn_s_sleep(1); \
    if ((++_sp & 255u) == 0u) { if (xb_ld(&(bar)[XB_TMO])) break; if (_sp > XB_SPIN_CAP) { atomicAdd(&(bar)[XB_TMO], 1u); break; } } } } while (0)

struct XcdBarrier {
    unsigned* bar; unsigned x;
    volatile LAS unsigned* st;
};

__device__ __forceinline__ XcdBarrier xcd_barrier_post(unsigned* bar, volatile LAS unsigned* st) {
    XcdBarrier b; b.bar = bar; b.x = xb_xcc_id(); b.st = st;
    if (threadIdx.x == 0) (void)xb_add(&bar[XB_XCNT(b.x)], 1u);
    return b;
}
__device__ __forceinline__ void xcd_barrier_complete(unsigned* bar, unsigned x, unsigned& nloc, unsigned& nx) {
    const unsigned G = gridDim.x * gridDim.y * gridDim.z;
    unsigned sum, cnt, mine, sp = 0u;
    for (;;) {
        sum = 0u; cnt = 0u; mine = 0u;
#pragma unroll
        for (unsigned j = 0; j < 16; ++j) { const unsigned c = xb_ld(&bar[XB_XCNT(j)]); sum += c; cnt += (c > 0u) ? 1u : 0u; mine = (j == x) ? c : mine; }
        if (sum == G) break;
        __builtin_amdgcn_s_sleep(1);
        if ((++sp & 255u) == 0u) { if (xb_ld(&bar[XB_TMO])) break; if (sp > XB_SPIN_CAP) { atomicAdd(&bar[XB_TMO], 1u); break; } }
    }
    nloc = mine > 0u ? mine : 1u; nx = cnt > 0u ? cnt : 1u;
}

__device__ __forceinline__ void xcd_barrier(const XcdBarrier& b) {
    asm volatile("s_waitcnt vmcnt(0)" ::: "memory");
    __syncthreads();
    if (threadIdx.x == 0) {
        unsigned* bar = b.bar;
        __builtin_amdgcn_s_waitcnt(0);
        unsigned nloc = b.st[0], nx = b.st[1];
        if (nloc == 0u) { xcd_barrier_complete(bar, b.x, nloc, nx); b.st[0] = nloc; b.st[1] = nx; }
        const unsigned old = xb_add(&bar[XB_XSUB(b.x)], 1u);
        const unsigned gen = old / nloc;
        if (old + 1u == (gen + 1u) * nloc) {
            __builtin_amdgcn_fence(__ATOMIC_RELEASE, "agent");
            asm volatile("s_waitcnt vmcnt(0)" ::: "memory");
            const unsigned og = xb_add(&bar[XB_TOP], 1u);
            const unsigned tg = og / nx;
            if (og + 1u == (tg + 1u) * nx) xb_add(&bar[XB_TOPGEN], 1u);
            else XB_SPIN(xb_ld(&bar[XB_TOPGEN]) == tg, bar);
            __builtin_amdgcn_fence(__ATOMIC_ACQUIRE, "agent");
            xb_add(&bar[XB_XGEN(b.x)], 1u);
            asm volatile("s_waitcnt vmcnt(0)" ::: "memory");
        } else {
            XB_SPIN(xb_ld(&bar[XB_XGEN(b.x)]) == gen, bar);
            __builtin_amdgcn_fence(__ATOMIC_ACQUIRE, "agent");
            asm volatile("s_waitcnt vmcnt(0)" ::: "memory");
        }
    }
    __syncthreads();
}

static __device__ unsigned g_bar[XCD_BAR_WORDS + 128];
#ifndef ONLY
#define PH(k) 1
#else
#define PH(k) ((k) == ONLY)
#endif
__global__ void __launch_bounds__(512) fwd_megakernel(Params P) {
    extern __shared__ __attribute__((aligned(16))) unsigned char lds_raw[];
    LAS unsigned char* lds = (LAS unsigned char*)lds_raw;
    cg::grid_group grid = cg::this_grid();
    unsigned char* ws = P.ws;
    const int G = gridDim.x, bx = blockIdx.x;
    volatile LAS unsigned* bst = (volatile LAS unsigned*)(lds + 131072 + 512);
    if (threadIdx.x < 2) bst[threadIdx.x] = 0u;
    __syncthreads();
    const XcdBarrier bar = xcd_barrier_post(g_bar, bst);
    if (P.flags == 0x7fffffff) grid.sync();
#define GRID_BAR() xcd_barrier(bar)

#if PH(0)
    phase0(P, lds);
    outw_phase(P, lds);
#endif
    GRID_BAR();
#if PH(1)
    ctx_kv(P, lds);
    phase1(P);
#endif
    GRID_BAR();
#if (PROBE_FLAGS + 0) & 1
    if (P.flags & 1) { phase0(P, lds); GRID_BAR(); phase1(P); GRID_BAR(); }
#endif
#if (PROBE_FLAGS + 0) & 16
    if (P.flags & 16) { GRID_BAR(); GRID_BAR(); GRID_BAR(); GRID_BAR(); }
#endif
#if PH(2)
    {
        pg8::Gemm g{(const bf16_t*)(ws + WS_H), (const bf16_t*)(ws + WS_WTIN), MTOK, 9216, DM};
        pg8::StaticOrder S; S.init(MTOK, 9216, G, bx);
        Epi1 E{(bf16_t*)(ws + WS_A2), (bf16_t*)(ws + WS_KB), (bf16_t*)(ws + WS_SZB), (bf16_t*)P.out, (bf16_t*)P.out + (size_t)MTOK * DM,
               (const float*)(ws + WS_ROPER), (const float*)(ws + WS_ROPEC), P.in[9], P.in[10], (float*)(ws + WS_EDGE), (LAS float*)(lds + 131072 + 1024)};
        pg8::gemm_phase<Epi1, pg8::StaticOrder, true, true, false, false>(lds, g, S, E);
#if (PROBE_FLAGS + 0) & 2
        if (P.flags & 2) { __syncthreads(); pg8::gemm_phase<Epi1, pg8::StaticOrder, true, true, false, false>(lds, g, S, E); }
#endif
    }
#endif
    __syncthreads();
#if PH(3)
    {
        pg8::Gemm g{(const bf16_t*)(ws + WS_H), (const bf16_t*)(ws + WS_WTIN) + (size_t)9216 * DM, MTOK, 1024, DM};
        pg8::StaticOrder S; S.init(MTOK, 1024, G, bx);
        EpiV E{(bf16_t*)(ws + WS_VT)};
        pg8::gemm_phase<EpiV, pg8::StaticOrder, true, true, true, false, true>(lds, g, S, E);
#if (PROBE_FLAGS + 0) & 32
        if (P.flags & 32) { __syncthreads(); pg8::gemm_phase<EpiV, pg8::StaticOrder, true, true, true, false, true>(lds, g, S, E); }
#endif
    }
#endif
    __syncthreads();
    GRID_BAR();
#if PH(5)
#if (PROBE_FLAGS + 0) & 4
    if (P.flags & 4) attn_phase(P, lds, (P.flags & 256) != 0);
#endif
    attn_phase(P, lds, true);
#endif
    conv_fixup(P);
    GRID_BAR();
#if PH(8)
    {
        pg8::Gemm g{(const bf16_t*)(ws + WS_A2), (const bf16_t*)(ws + WS_W2T), MTOK, 1024, 2048};
        pg8::StaticOrder S; S.init(MTOK, 1024, G, bx);
        Epi2 E{(const bf16_t*)P.out, (const bf16_t*)P.out + (size_t)MTOK * DM, (bf16_t*)(ws + WS_MRG)};
#if (PROBE_FLAGS + 0) & 8
        if (P.flags & 8) { Epi2 E2{(const bf16_t*)P.out, (const bf16_t*)P.out + (size_t)MTOK * DM, (bf16_t*)(ws + WS_MRG)}; pg8::gemm_phase<Epi2, pg8::StaticOrder, false, true, false, true>(lds, g, S, E2); __syncthreads(); }
#endif
        pg8::gemm_phase<Epi2, pg8::StaticOrder, true, true, false, true>(lds, g, S, E);
    }
#endif
    GRID_BAR();
#if PH(9)
    {
        pg8::Gemm g{(const bf16_t*)(ws + WS_MRG), (const bf16_t*)(ws + WS_WOT), MTOK, 1024, DM};
        pg8::StaticOrder S; S.init(MTOK, 1024, G, bx);
        EpiOut E{P.in[0], P.out, (const float*)(ws + WS_MOD), P.in[7], (float*)(ws + WS_XBUF), (unsigned*)(ws + WS_CNT)};
        pg8::gemm_phase<EpiOut, pg8::StaticOrder, false, true, false, false>(lds, g, S, E);
    }
#endif
    __syncthreads();
    if (threadIdx.x == 0) {
        const unsigned old = __hip_atomic_fetch_add(&g_bar[XCD_BAR_WORDS + 64], 1u, __ATOMIC_RELAXED, __HIP_MEMORY_SCOPE_AGENT);
        if (old == (unsigned)G - 1u) {
            __hip_atomic_store(&g_bar[XB_TMO], 0u, __ATOMIC_RELAXED, __HIP_MEMORY_SCOPE_AGENT);
            for (int j = 0; j < 16; ++j) { __hip_atomic_store(&g_bar[XB_XCNT(j)], 0u, __ATOMIC_RELAXED, __HIP_MEMORY_SCOPE_AGENT); __hip_atomic_store(&g_bar[XB_XSUB(j)], 0u, __ATOMIC_RELAXED, __HIP_MEMORY_SCOPE_AGENT);
                __hip_atomic_store(&g_bar[XB_XGEN(j)], 0u, __ATOMIC_RELAXED, __HIP_MEMORY_SCOPE_AGENT); }
            __hip_atomic_store(&g_bar[XB_TOP], 0u, __ATOMIC_RELAXED, __HIP_MEMORY_SCOPE_AGENT); __hip_atomic_store(&g_bar[XB_TOPGEN], 0u, __ATOMIC_RELAXED, __HIP_MEMORY_SCOPE_AGENT);
            __hip_atomic_store(&g_bar[XCD_BAR_WORDS + 64], 0u, __ATOMIC_RELAXED, __HIP_MEMORY_SCOPE_AGENT);
        }
    }
}

extern "C" void kernel_launch(void* const* d_in, const int* in_sizes, int n_in, void* d_out, int out_size, void* d_ws, size_t ws_size, hipStream_t stream) {
    static int grid = 0;
    if (grid == 0) {
        if (n_in != 15 || in_sizes[0] != MTOK * DM || out_size != MTOK * DM || ws_size < WS_END) {
            fprintf(stderr, "kernel_launch: unexpected shapes (n_in %d, in0 %d, out %d, ws %zu)\n", n_in, n_in > 0 ? in_sizes[0] : -1, out_size, ws_size); grid = -1; return; }
        int dev = 0, cus = 0, per_cu = 0;
        (void)hipGetDevice(&dev); (void)hipDeviceGetAttribute(&cus, hipDeviceAttributeMultiprocessorCount, dev);
        if (hipFuncSetAttribute((const void*)fwd_megakernel, hipFuncAttributeMaxDynamicSharedMemorySize, LDS_BYTES) != hipSuccess) { fprintf(stderr, "kernel_launch: hipFuncSetAttribute failed\n"); grid = -1; return; }
        if (hipOccupancyMaxActiveBlocksPerMultiprocessor(&per_cu, (const void*)fwd_megakernel, 512, LDS_BYTES) != hipSuccess || per_cu < 1) { fprintf(stderr, "kernel_launch: occupancy query says %d\n", per_cu); per_cu = 1; }
        (void)hipGetLastError();
        grid = cus > 0 ? cus : 256;
        if (grid % 8 != 0) grid -= grid % 8;
    }
    if (grid < 0) return;
    Params p{};
    for (int i = 0; i < 15; ++i) p.in[i] = (const float*)d_in[i];
    p.out = (float*)d_out; p.ws = (unsigned char*)d_ws;
    p.flags = PROBE_FLAGS;
    void* args[] = {&p};
    hipError_t e = hipLaunchCooperativeKernel((const void*)fwd_megakernel, dim3(grid), dim3(512), args, LDS_BYTES, stream);
    if (e != hipSuccess) fprintf(stderr, "kernel_launch: cooperative launch failed: %s (grid %d)\n", hipGetErrorString(e), grid);
}
```
